# Optimizing an MI355X kernel written in HIP

```python
import math
import jax, jax.numpy as jnp
from jax import lax
import numpy as np

D_MODEL = 1024
BATCH = 4
SEQ = 4096
DEPTH = 2

GLA_HEADS = 4
GLA_DK = 64
GLA_DV = 128
GLA_KEY = GLA_HEADS * GLA_DK
GLA_VAL = GLA_HEADS * GLA_DV
GATE_RANK = 16
GATE_NORMALIZER = 16.0
CHUNK = 64
CONV_CH = 512
CONV_WIDTH = 31
MIX_WIDTH = GLA_VAL + CONV_CH
IN_COLS = 2 * GLA_KEY + 2 * GLA_VAL + GATE_RANK + 2 * CONV_CH
D_FF = 2816
N_EXPERTS = 8
TOP_K = 2
N_DENSE = (DEPTH + 1) // 2
N_MOE = DEPTH // 2
EPS = 1e-6

kernel_name = "hybrid_gla_conformer_moe_trunk"


def rmsnorm(x, w):
    xf = x.astype(jnp.float32)
    y = xf * lax.rsqrt(jnp.mean(xf * xf, axis=-1, keepdims=True) + EPS)
    return (y * w.astype(jnp.float32)).astype(x.dtype)


def layernorm(x, w, b):
    xf = x.astype(jnp.float32)
    mu = jnp.mean(xf, axis=-1, keepdims=True)
    var = jnp.mean(jnp.square(xf - mu), axis=-1, keepdims=True)
    y = (xf - mu) * lax.rsqrt(var + EPS)
    return (y * w.astype(jnp.float32) + b.astype(jnp.float32)).astype(x.dtype)


def gla_chunked(q, k, v, log_a):
    B, H, T, DK = q.shape
    DV = v.shape[-1]
    N = T // CHUNK

    def to_chunks(a):
        return a.astype(jnp.float32).reshape(B, H, N, CHUNK, a.shape[-1]).transpose(2, 0, 1, 3, 4)

    qc, kc, vc, ac = to_chunks(q), to_chunks(k), to_chunks(v), to_chunks(log_a)
    bc = jnp.cumsum(ac, axis=3)
    mask = jnp.tril(jnp.ones((CHUNK, CHUNK), dtype=bool))

    def step(S, inp):
        qi, ki, vi, bi = inp
        diff = bi[:, :, :, None, :] - bi[:, :, None, :, :]
        decay = jnp.exp(jnp.where(mask[:, :, None], diff, -jnp.inf))
        attn = jnp.einsum('bhid,bhjd,bhijd->bhij', qi, ki, decay)
        o_intra = jnp.einsum('bhij,bhjv->bhiv', attn, vi)
        o_inter = jnp.einsum('bhid,bhdv->bhiv', qi * jnp.exp(bi), S)
        b_last = bi[:, :, -1:, :]
        S_new = jnp.exp(b_last[:, :, 0, :])[..., None] * S + jnp.einsum(
            'bhjd,bhjv->bhdv', ki * jnp.exp(b_last - bi), vi)
        return S_new, o_intra + o_inter

    S0 = jnp.zeros((B, H, DK, DV), jnp.float32)
    _, ys = lax.scan(step, S0, (qc, kc, vc, bc))
    return ys.transpose(1, 2, 0, 3, 4).reshape(B, H, T, DV)


def causal_dwconv(u, w, b):
    kern = w[:, None, :].astype(u.dtype)
    y = lax.conv_general_dilated(u, kern, window_strides=(1,), padding=[(CONV_WIDTH - 1, 0)],
                                 dimension_numbers=('NWC', 'WIO', 'NWC'), feature_group_count=CONV_CH)
    return y + b.astype(u.dtype)


def swiglu(h, wg, wu, wd):
    return (jax.nn.silu(h @ wg) * (h @ wu)) @ wd


def token_mixer(h, w_in, w_gate_up, b_gate, gla_norm_w, conv_w, conv_b, cn_w, cn_b, w_out):
    B, T, _ = h.shape
    z = h @ w_in
    sizes = [GLA_KEY, GLA_KEY, GLA_VAL, GLA_VAL, GATE_RANK, CONV_CH, CONV_CH]
    offs = np.cumsum([0] + sizes)
    q, k, v, g, gr, ca, cb = [z[..., offs[i]:offs[i + 1]] for i in range(len(sizes))]

    gate_logit = (gr @ w_gate_up + b_gate).astype(jnp.float32)
    log_a = jax.nn.log_sigmoid(gate_logit) / GATE_NORMALIZER

    def heads(a, d):
        return a.reshape(B, T, GLA_HEADS, d).transpose(0, 2, 1, 3)

    o = gla_chunked(heads(q, GLA_DK) * (GLA_DK ** -0.5), heads(k, GLA_DK), heads(v, GLA_DV),
                    heads(log_a, GLA_DK))
    o = o.transpose(0, 2, 1, 3).astype(h.dtype)
    o = rmsnorm(o, gla_norm_w)
    o = (o * jax.nn.silu(g.reshape(B, T, GLA_HEADS, GLA_DV))).reshape(B, T, GLA_VAL)

    u = ca * jax.nn.sigmoid(cb)
    u = causal_dwconv(u, conv_w, conv_b)
    u = jax.nn.silu(layernorm(u, cn_w, cn_b))

    return jnp.concatenate([o, u], axis=-1) @ w_out


def moe_swiglu(h, w_router, we_gate, we_up, we_down):
    B, T, D = h.shape
    hf = h.reshape(B * T, D)
    logits = (hf @ w_router).astype(jnp.float32)
    top_v, top_i = lax.top_k(logits, TOP_K)
    gates = jax.nn.softmax(top_v, axis=-1)
    comb = jnp.sum(jax.nn.one_hot(top_i, N_EXPERTS, dtype=jnp.float32) * gates[..., None], axis=1)
    comb = comb.astype(h.dtype)
    y = jnp.zeros_like(hf)
    for e in range(N_EXPERTS):
        y = y + comb[:, e:e + 1] * swiglu(hf, we_gate[e], we_up[e], we_down[e])
    return y.reshape(B, T, D)


def setup_inputs(seed: int = 0) -> dict:
    key = jax.random.key(seed)
    ks = jax.random.split(key, 24)
    f32 = jnp.float32
    nrm = lambda k, s, sc: jax.random.normal(k, s, f32) * sc
    D = D_MODEL
    return {
        "x": jax.random.normal(ks[0], (BATCH, SEQ, D), f32),
        "ln1_w": 1.0 + nrm(ks[1], (DEPTH, D), 0.02),
        "w_in": nrm(ks[2], (DEPTH, D, IN_COLS), D ** -0.5),
        "w_gate_up": nrm(ks[3], (DEPTH, GATE_RANK, GLA_KEY), GATE_RANK ** -0.5),
        "b_gate": nrm(ks[4], (DEPTH, GLA_KEY), 0.1),
        "gla_norm_w": 1.0 + nrm(ks[5], (DEPTH, GLA_DV), 0.02),
        "conv_w": nrm(ks[6], (DEPTH, CONV_WIDTH, CONV_CH), CONV_WIDTH ** -0.5),
        "conv_b": nrm(ks[7], (DEPTH, CONV_CH), 0.02),
        "cn_w": 1.0 + nrm(ks[8], (DEPTH, CONV_CH), 0.02),
        "cn_b": nrm(ks[9], (DEPTH, CONV_CH), 0.02),
        "w_out": nrm(ks[10], (DEPTH, MIX_WIDTH, D), MIX_WIDTH ** -0.5),
        "ln2_w": 1.0 + nrm(ks[11], (DEPTH, D), 0.02),
        "wd_gate": nrm(ks[12], (N_DENSE, D, D_FF), D ** -0.5),
        "wd_up": nrm(ks[13], (N_DENSE, D, D_FF), D ** -0.5),
        "wd_down": nrm(ks[14], (N_DENSE, D_FF, D), D_FF ** -0.5),
        "w_router": nrm(ks[15], (N_MOE, D, N_EXPERTS), D ** -0.5),
        "we_gate": nrm(ks[16], (N_MOE, N_EXPERTS, D, D_FF), D ** -0.5),
        "we_up": nrm(ks[17], (N_MOE, N_EXPERTS, D, D_FF), D ** -0.5),
        "we_down": nrm(ks[18], (N_MOE, N_EXPERTS, D_FF, D), D_FF ** -0.5),
        "final_norm_w": 1.0 + nrm(ks[19], (D,), 0.02),
    }


def reference(x, ln1_w, w_in, w_gate_up, b_gate, gla_norm_w, conv_w, conv_b, cn_w, cn_b, w_out,
              ln2_w, wd_gate, wd_up, wd_down, w_router, we_gate, we_up, we_down, final_norm_w):
    for l in range(DEPTH):
        h = rmsnorm(x, ln1_w[l])
        x = x + token_mixer(h, w_in[l], w_gate_up[l], b_gate[l], gla_norm_w[l], conv_w[l], conv_b[l],
                            cn_w[l], cn_b[l], w_out[l])
        h = rmsnorm(x, ln2_w[l])
        if l % 2 == 0:
            i = l // 2
            x = x + swiglu(h, wd_gate[i], wd_up[i], wd_down[i])
        else:
            i = l // 2
            x = x + moe_swiglu(h, w_router[i], we_gate[i], we_up[i], we_down[i])
    return rmsnorm(x, final_norm_w)
```

```cpp
#include <hip/hip_runtime.h>
#include <cstdio>
#include <cstdint>

typedef unsigned short bf16;
typedef unsigned v4u __attribute__((ext_vector_type(4)));
typedef float f32x4 __attribute__((ext_vector_type(4)));
#define LAS __attribute__((address_space(3)))

constexpr int D = 1024, NB = 4, T = 4096, M = NB * T;
constexpr int H = 4, DK = 64, DV = 128, KEY = 256, VAL = 512, RANK = 16, CCH = 512, CW = 31;
constexpr int INC = 2576, NIN = 2816;
constexpr int FF = 2816, NE = 8, NGU = 2 * FF;
constexpr float EPS = 1e-6f;
constexpr int CHUNK = 64, NCH = T / CHUNK;

constexpr size_t MiB = 1u << 20;
constexpr size_t WS_CTL = 0;
constexpr size_t WS_WMGU = 2 * MiB;
constexpr size_t WS_WMD = 46 * MiB;
constexpr size_t WS_XB8 = 68 * MiB;
constexpr size_t WS_WIN1 = 134 * MiB;
constexpr size_t WS_WOUT1 = 140 * MiB;
constexpr size_t WS_XB = 142 * MiB;
constexpr size_t WS_SSQ = 174 * MiB;
constexpr size_t WS_MISC = 175 * MiB;
constexpr size_t WS_WIN0 = 177 * MiB;
constexpr size_t WS_WOUT0 = 183 * MiB;
constexpr size_t WS_WDGU = 185 * MiB;
constexpr size_t WS_WDD = 196 * MiB;
constexpr size_t WS_TMP = 202 * MiB;
constexpr size_t WS_QS = WS_TMP, WS_KB = WS_TMP + 8 * MiB, WS_VB = WS_TMP + 16 * MiB, WS_SG = WS_TMP + 32 * MiB, WS_LA = WS_TMP + 48 * MiB, WS_UB = WS_TMP + 64 * MiB;
constexpr size_t WS_QT = WS_TMP + 80 * MiB, WS_OI = WS_TMP + 88 * MiB, WS_DS = WS_TMP + 104 * MiB, WS_SP = WS_TMP + 136 * MiB, WS_MIX = WS_TMP + 152 * MiB;
constexpr size_t WS_ACT = WS_TMP;
constexpr size_t WS_END = WS_TMP + 184 * MiB;
constexpr size_t MI_SEL = 0, MI_DEC = 768 * 1024;

__device__ __forceinline__ float bf2f(bf16 b) { return __uint_as_float(((unsigned)b) << 16); }
__device__ __forceinline__ unsigned f2bf(float f) { unsigned u = __float_as_uint(f); return (u + 0x7fffu + ((u >> 16) & 1u)) >> 16; }
__device__ __forceinline__ unsigned pk2(float lo, float hi) { return f2bf(lo) | (f2bf(hi) << 16); }
__device__ __forceinline__ float sigmoidf_(float x) { return 1.f / (1.f + __expf(-x)); }
__device__ __forceinline__ float siluf_(float x) { return x / (1.f + __expf(-x)); }
__device__ __forceinline__ float logsigf_(float x) { return fminf(x, 0.f) - log1pf(__expf(-fabsf(x))); }
__device__ __forceinline__ float wave_sum(float v) {
#pragma unroll
    for (int o = 1; o < 64; o <<= 1) v += __shfl_xor(v, o);
    return v;
}
__device__ __forceinline__ float row_rstd(const float* ssq, int row) {
    const f32x4* p = (const f32x4*)(ssq + (size_t)row * 16);
    f32x4 a = p[0], b = p[1], c = p[2], d = p[3];
    float s = ((a.x + a.y) + (a.z + a.w)) + ((b.x + b.y) + (b.z + b.w)) + ((c.x + c.y) + (c.z + c.w)) + ((d.x + d.y) + (d.z + d.w));
    return rsqrtf(s * (1.f / D) + EPS);
}

struct Inputs {
    const float *x, *ln1_w, *w_in, *w_gate_up, *b_gate, *gla_norm_w, *conv_w, *conv_b, *cn_w, *cn_b, *w_out, *ln2_w, *wd_gate, *wd_up, *wd_down, *w_router, *we_gate, *we_up, *we_down, *final_w;
};

constexpr float W8_MUL = 64.f;
struct CvtP { const float* W; const float* scale; void* WT; int ld, col0, K, row0, kb, nb, fp8; };
__device__ __forceinline__ void cvt_load(const CvtP& P, f32x4 (&v)[16], int lane) {
    const int k0 = 64 * P.kb, n0 = 64 * P.nb, n4 = 4 * (lane & 15), kq = lane >> 4;
#pragma unroll
    for (int i = 0; i < 16; ++i) v[i] = *(const f32x4*)(P.W + (size_t)(k0 + kq + 4 * i) * P.ld + P.col0 + n0 + n4);
}
__device__ __forceinline__ void cvt_finish(const CvtP& P, f32x4 (&v)[16], LAS float* scr, int lane) {
    const int k0 = 64 * P.kb, n0 = 64 * P.nb, n4 = 4 * (lane & 15), kq = lane >> 4; const float mul = P.fp8 ? W8_MUL : 1.f;
#pragma unroll
    for (int i = 0; i < 16; ++i) v[i] *= P.scale ? P.scale[k0 + kq + 4 * i] * mul : mul;
#pragma unroll
    for (int i = 0; i < 16; ++i) { const int k = kq + 4 * i; *(LAS f32x4*)(scr + k * 64 + (n4 ^ (4 * (k >> 3)))) = v[i]; }
    asm volatile("s_waitcnt lgkmcnt(0)" ::: "memory");
    if (P.fp8) { const int c = lane & 3; unsigned char* WT = (unsigned char*)P.WT;
#pragma unroll
        for (int j = 0; j < 4; ++j) { const int n = (lane >> 2) + 16 * j; unsigned w[4];
#pragma unroll
            for (int q = 0; q < 4; ++q) { float x[4];
#pragma unroll
                for (int r = 0; r < 4; ++r) { const int k = 16 * c + 4 * q + r; x[r] = scr[k * 64 + (n ^ (4 * (k >> 3)))]; }
                int t = 0; t = __builtin_amdgcn_cvt_pk_fp8_f32(x[0], x[1], t, false); t = __builtin_amdgcn_cvt_pk_fp8_f32(x[2], x[3], t, true); w[q] = (unsigned)t; }
            *(v4u*)(WT + (size_t)(P.row0 + n0 + n) * P.K + k0 + 16 * c) = (v4u){w[0], w[1], w[2], w[3]}; }
    } else { const int c = lane & 7; bf16* WT = (bf16*)P.WT;
#pragma unroll
        for (int j = 0; j < 8; ++j) { const int n = (lane >> 3) + 8 * j; const LAS float* sp = scr + (8 * c) * 64 + (n ^ (4 * c));
            v4u o; o.x = pk2(sp[0 * 64], sp[1 * 64]); o.y = pk2(sp[2 * 64], sp[3 * 64]); o.z = pk2(sp[4 * 64], sp[5 * 64]); o.w = pk2(sp[6 * 64], sp[7 * 64]);
            *(v4u*)(WT + (size_t)(P.row0 + n0 + n) * P.K + k0 + 8 * c) = o; }
    }
    asm volatile("s_waitcnt lgkmcnt(0)" ::: "memory");
}
constexpr int CVT_ITEMS = (20 + 20 + 8 + 8 + 44) * 32 + 8 * 88 + 8 * 44 * 32 + 8 * 8 * 88;
__device__ __forceinline__ CvtP cvt_decode(const Inputs& I, unsigned char* ws, int it) {
    CvtP P; int job, r = it; P.fp8 = 0; P.scale = nullptr; P.K = 1024;
    if (r < 40 * 32) { job = r / (20 * 32); r -= job * 20 * 32; const int seg = r / 32, q = r % 32;
        if (seg < 12) { P.col0 = 128 * seg; P.row0 = 128 * seg; } else { const int t = (seg - 12) >> 1, hf = (seg - 12) & 1; P.col0 = (hf ? 2064 : 1552) + 128 * t; P.row0 = 1792 + 256 * t + 128 * hf; }
        P.W = I.w_in + (size_t)job * D * INC; P.ld = INC; P.WT = ws + (job ? WS_WIN1 : WS_WIN0); P.scale = I.ln1_w + job * D; P.kb = q >> 1; P.nb = q & 1; return P; }
    r -= 40 * 32;
    if (r < 16 * 32) { job = r / (8 * 32); r -= job * 8 * 32; const int seg = r / 32, q = r % 32;
        P.W = I.w_out + (size_t)job * D * D; P.ld = D; P.col0 = 128 * seg; P.row0 = 128 * seg; P.WT = ws + (job ? WS_WOUT1 : WS_WOUT0); P.kb = q >> 1; P.nb = q & 1; return P; }
    r -= 16 * 32;
    if (r < 44 * 32) { const int seg = r / 32, q = r % 32, t = seg >> 1, hf = seg & 1;
        P.W = hf ? I.wd_up : I.wd_gate; P.ld = FF; P.col0 = 128 * t; P.row0 = 256 * t + 128 * hf; P.WT = ws + WS_WDGU; P.scale = I.ln2_w; P.kb = q >> 1; P.nb = q & 1; return P; }
    r -= 44 * 32;
    if (r < 8 * 88) { const int seg = r / 88, q = r % 88;
        P.W = I.wd_down; P.ld = D; P.col0 = 128 * seg; P.row0 = 128 * seg; P.K = FF; P.WT = ws + WS_WDD; P.kb = q >> 1; P.nb = q & 1; return P; }
    r -= 8 * 88;
    if (r < 8 * 44 * 32) { const int e = r / (44 * 32); r -= e * 44 * 32; const int seg = r / 32, q = r % 32, t = seg >> 1, hf = seg & 1;
        P.W = (hf ? I.we_up : I.we_gate) + (size_t)e * D * FF; P.ld = FF; P.col0 = 128 * t; P.row0 = 256 * t + 128 * hf; P.WT = ws + WS_WMGU + (size_t)e * NGU * D; P.scale = I.ln2_w + D; P.fp8 = 1; P.kb = q >> 1; P.nb = q & 1; return P; }
    r -= 8 * 44 * 32;
    { const int e = r / (8 * 88); r -= e * 8 * 88; const int seg = r / 88, q = r % 88;
        P.W = I.we_down + (size_t)e * FF * D; P.ld = D; P.col0 = 128 * seg; P.row0 = 128 * seg; P.K = FF; P.WT = ws + WS_WMD + (size_t)e * D * FF; P.fp8 = 1; P.kb = q >> 1; P.nb = q & 1; return P; }
}
__device__ __forceinline__ void cvt_all(const Inputs& I, unsigned char* ws, int gw, int NGW, LAS float* scr, int lane) {
    int it = gw; if (it >= CVT_ITEMS) return;
    CvtP P = cvt_decode(I, ws, it); f32x4 v[16]; cvt_load(P, v, lane);
    for (;;) { const int itn = it + NGW; const bool more = itn < CVT_ITEMS;
        CvtP Pn = P; f32x4 vn[16];
        if (more) { Pn = cvt_decode(I, ws, itn); cvt_load(Pn, vn, lane); }
        cvt_finish(P, v, scr, lane);
        if (!more) break;
        P = Pn; it = itn;
#pragma unroll
        for (int i = 0; i < 16; ++i) v[i] = vn[i];
    }
}
__device__ __forceinline__ void cvt_gate_elem(const Inputs& I, unsigned char* ws, int idx) {
    const int l = idx >> 18, j = (idx >> 10) & 255, k = idx & 1023;
    const float* wr = I.w_in + (size_t)l * D * INC + (size_t)k * INC + 1536; const float* gu = I.w_gate_up + l * RANK * KEY + j;
    float s = 0.f;
#pragma unroll
    for (int r = 0; r < RANK; ++r) s += wr[r] * gu[r * KEY];
    bf16* dst = (bf16*)(ws + (l ? WS_WIN1 : WS_WIN0));
    dst[(size_t)(1536 + j) * D + k] = (bf16)f2bf(s * I.ln1_w[l * D + k]);
}
__device__ __forceinline__ void row_to_xb(const float* xrow, bf16* orow, float* ssqrow, int lane) {
    const f32x4* xr = (const f32x4*)xrow + lane; f32x4 v[4]; float s = 0.f;
#pragma unroll
    for (int j = 0; j < 4; ++j) { v[j] = xr[64 * j]; s += (v[j].x * v[j].x + v[j].y * v[j].y) + (v[j].z * v[j].z + v[j].w * v[j].w); }
    s = wave_sum(s);
    unsigned long long* o8 = (unsigned long long*)orow + lane;
#pragma unroll
    for (int j = 0; j < 4; ++j) o8[64 * j] = (unsigned long long)pk2(v[j].x, v[j].y) | ((unsigned long long)pk2(v[j].z, v[j].w) << 32);
    if (lane < 16) ssqrow[lane] = lane == 0 ? s : 0.f;
}

__device__ __forceinline__ int opaque_tid() { int t = threadIdx.x; asm volatile("" : "+v"(t)); return t; }
namespace pg8 {
#define PG8_LAS __attribute__((address_space(3)))
typedef short bf16x8 __attribute__((ext_vector_type(8)));
typedef unsigned u32x4 __attribute__((ext_vector_type(4)));
constexpr int BM = 256, BK = 64, HALF = 128, HTB = HALF * BK * 2  , STAGE_BYTES = 8 * HTB, NXCD = 8, WGM = 8;

__host__ __device__ __forceinline__ int lds_byte(int r, int c) { return r * 128 + ((((c >> 3) ^ ((r >> 1) & 7)) << 4)) + (c & 7) * 2; }
__host__ __device__ __forceinline__ void stage_rc(int b, int& R, int& C) { R = b >> 7; C = (((b >> 4) & 7) ^ ((R >> 1) & 7)) * 8; }
__host__ __device__ __forceinline__ int perm32(int rho) { const int n = rho >> 4, i = rho & 15; return 8 * (i >> 2) + 4 * n + (i & 3); }

struct Unit { int pm, pn, e, hm; };

__device__ __forceinline__ void unit_of(int wgid, int nM, int NN, int q, int r, int& pm, int& pn) {
    { const int xcd = wgid & (NXCD - 1), off = wgid >> 3; wgid = (xcd < r ? xcd * (q + 1) : r * (q + 1) + (xcd - r) * q) + off; }
    const int nig = WGM * NN, gid = wgid / nig, fm = gid * WGM, gsz = (nM - fm) < WGM ? (nM - fm) : WGM, rem = wgid - gid * nig;
    if (gsz == WGM) { pm = fm + (rem & (WGM - 1)); pn = rem >> 3; } else { pm = fm + rem % gsz; pn = rem / gsz; }
}
template <int NN, bool SPLIT = false> struct StaticOrder {
    static constexpr bool GATHER = false;
    int nM, nwg, G, c, q, r, nfull; const bf16* Bt;
    __device__ void init(int nM_, int G_, int c_, const bf16* Bt_) { nM = nM_; nwg = nM * NN; G = G_; c = c_; Bt = Bt_; q = nwg >> 3; r = nwg & 7; nfull = (SPLIT && 2 * (nwg % G) <= G) ? (nwg / G) * G : nwg; }
    __device__ __forceinline__ bool next(int i, Unit& u) const { int L = i * G + c; u.hm = -1; u.e = 0;
        if (L >= nfull) { const int j = L - nfull; if (j >= 2 * (nwg - nfull)) return false; L = nfull + (j >> 1); u.hm = j & 1; }
        unit_of(L, nM, NN, q, r, u.pm, u.pn); return true; }
    __device__ __forceinline__ const void* bt_root() const { return Bt; }
    __device__ __forceinline__ int bt_off(const Unit&) const { return 0; }
    __device__ __forceinline__ int row_src(const Unit&, int) const { return 0; }
};
template <bool GATHER_, int NN, bool SPLIT = false> struct MoeOrder {
    static constexpr bool GATHER = GATHER_;
    int nM, nwg, G, c, q, r, nfull; const char* Bt; size_t estride; const PG8_LAS int* tile_e; const int* rowinfo;
    __device__ void init(int nM_, int G_, int c_, const void* Bt_, size_t estride_, const PG8_LAS int* tile_e_, const int* rowinfo_) { nM = nM_; nwg = nM * NN; G = G_; c = c_; Bt = (const char*)Bt_; estride = estride_; tile_e = tile_e_; rowinfo = rowinfo_; q = nwg >> 3; r = nwg & 7;
        nfull = (SPLIT && 2 * (nwg % G) <= G) ? (nwg / G) * G : nwg; }
    __device__ __forceinline__ bool next(int i, Unit& u) const { int L = i * G + c; u.hm = -1;
        if (L >= nfull) { const int j = L - nfull; if (j >= 2 * (nwg - nfull)) return false; L = nfull + (j >> 1); u.hm = j & 1; }
        unit_of(L, nM, NN, q, r, u.pm, u.pn); u.e = __builtin_amdgcn_readfirstlane(tile_e[u.pm]); return true; }
    __device__ __forceinline__ const void* bt_root() const { return Bt; }
    __device__ __forceinline__ int bt_off(const Unit& u) const { return u.e * (int)estride; }
    __device__ __forceinline__ int row_src(const Unit& u, int R) const { return __hip_atomic_load(rowinfo + u.pm * BM + (u.hm > 0 ? HALF : 0) + R, __ATOMIC_RELAXED, __HIP_MEMORY_SCOPE_AGENT) & 0x3fff; }
};

typedef int v4i_ __attribute__((ext_vector_type(4)));
typedef int v8i_ __attribute__((ext_vector_type(8)));
__device__ __forceinline__ v8i_ cat8(const bf16x8 a, const bf16x8 b) { const v4i_ x = __builtin_bit_cast(v4i_, a), y = __builtin_bit_cast(v4i_, b); return __builtin_shufflevector(x, y, 0, 1, 2, 3, 4, 5, 6, 7); }
__device__ __forceinline__ unsigned cvt_pk_bf16(float lo, float hi) { unsigned r; asm volatile("v_cvt_pk_bf16_f32 %0, %1, %2" : "=v"(r) : "v"(lo), "v"(hi)); return r; }
__device__ __forceinline__ u32x4 pack8(const f32x4 a, const f32x4 b) { u32x4 w; w.x = cvt_pk_bf16(a[0], a[1]); w.y = cvt_pk_bf16(a[2], a[3]); w.z = cvt_pk_bf16(b[0], b[1]); w.w = cvt_pk_bf16(b[2], b[3]); return w; }

template <class Epi, class Sched, bool ALIGN_EPI = false, bool SP2 = false, bool FP8 = false, int SCALE_W = 0x7f7f7f7f, int SCALE_X = 0x7f7f7f7f>
__device__ __forceinline__ void gemm_phase(PG8_LAS unsigned char* lds, PG8_LAS float* tab, const void* Abase, const int K, const Sched& S, const Epi& E) {
    const int tid = opaque_tid(), wid = __builtin_amdgcn_readfirstlane(tid >> 6), lane = tid & 63, wr = wid >> 2, wc = wid & 3, fr = lane & 15, fq = lane >> 4;
    const int rowb = FP8 ? K : 2 * K;
    const int nt = rowb / 128;
    Unit cur, nxt; int ui = 0;
    if (!S.next(0, cur)) return;
    bool has_next = S.next(1, nxt);
    E.prep_store(E.prep_load(cur, tid), tab, 0, tid); __builtin_amdgcn_sched_barrier(0);
    const int kstep = BK * 2;
    const int hstep = HALF * rowb;
    const int tstep = 2 * hstep;
    unsigned voffB[2], vA[2][2], vN[2][2];
#pragma unroll
    for (int i = 0; i < 2; ++i) { int R, C; stage_rc(tid * 16 + i * 8192, R, C); const int Rb = Epi::PERM ? ((R & ~31) + perm32(R & 31)) : R;
        voffB[i] = (unsigned)(Rb * rowb + C * 2);
#pragma unroll
        for (int h = 0; h < 2; ++h) { vA[h][i] = (unsigned)(R * rowb + C * 2); vN[h][i] = vA[h][i]; } }
    const int hA = Sched::GATHER ? 0 : hstep;
    const unsigned ldsw = (unsigned)wid * 1024u;
    const int aoff0 = lds_byte(wr * 64 + fr, fq * 8), aoff1 = lds_byte(wr * 64 + fr, 32 + fq * 8), boff0 = lds_byte(wc * 32 + fr, fq * 8), boff1 = lds_byte(wc * 32 + fr, 32 + fq * 8);
#define PG8_SA(b, h) (((b) * 2 + (h)) * HTB)
#define PG8_SB(b, h) ((4 + (b) * 2 + (h)) * HTB)
#define PG8_STAGE(bufoff, rsrc, soff, voff) do { _Pragma("unroll") for (int _i = 0; _i < 2; ++_i) \
        __builtin_amdgcn_raw_ptr_buffer_load_lds(rsrc, (PG8_LAS void*)(lds + (bufoff) + ldsw + _i * 8192), 16, (int)(voff)[_i], (int)(soff), 0, 0); } while (0)
#define PG8_LD8(p0, p1) __builtin_shufflevector(*(const PG8_LAS v4i_*)(p0), *(const PG8_LAS v4i_*)(p1), 0, 1, 2, 3, 4, 5, 6, 7)
#define PG8_LDA(dst, b, h) do { if constexpr (FP8) { _Pragma("unroll") for (int m = 0; m < 4; ++m) dst##8[m] = PG8_LD8(lds + PG8_SA(b, h) + aoff0 + m * 2048, lds + PG8_SA(b, h) + aoff1 + m * 2048); } else { \
        _Pragma("unroll") for (int m = 0; m < 4; ++m) { dst[m][0] = *(const PG8_LAS bf16x8*)(lds + PG8_SA(b, h) + aoff0 + m * 2048); dst[m][1] = *(const PG8_LAS bf16x8*)(lds + PG8_SA(b, h) + aoff1 + m * 2048); } } } while (0)
#define PG8_LDB(dst, b, h) do { if constexpr (FP8) { _Pragma("unroll") for (int n = 0; n < 2; ++n) dst##8[n] = PG8_LD8(lds + PG8_SB(b, h) + boff0 + n * 2048, lds + PG8_SB(b, h) + boff1 + n * 2048); } else { \
        _Pragma("unroll") for (int n = 0; n < 2; ++n) { dst[n][0] = *(const PG8_LAS bf16x8*)(lds + PG8_SB(b, h) + boff0 + n * 2048); dst[n][1] = *(const PG8_LAS bf16x8*)(lds + PG8_SB(b, h) + boff1 + n * 2048); } } } while (0)
#define PG8_MMA(ai, bj, At, Bt) do { __builtin_amdgcn_s_setprio(1); if constexpr (FP8) { _Pragma("unroll") for (int m = 0; m < 4; ++m) _Pragma("unroll") for (int n = 0; n < 2; ++n) \
        asm volatile("v_mfma_scale_f32_16x16x128_f8f6f4 %0, %1, %2, %0, %3, %4 op_sel_hi:[0,0,0]" : "+v"(acc[ai][bj][m][n]) : "v"(Bt##8[n]), "v"(At##8[m]), "v"(scw), "v"(scx)); } else { \
        _Pragma("unroll") for (int m = 0; m < 4; ++m) _Pragma("unroll") for (int n = 0; n < 2; ++n) _Pragma("unroll") for (int k = 0; k < 2; ++k) \
        acc[ai][bj][m][n] = __builtin_amdgcn_mfma_f32_16x16x32_bf16(Bt[n][k], At[m][k], acc[ai][bj][m][n], 0, 0, 0); } __builtin_amdgcn_s_setprio(0); } while (0)
#define PG8_WAIT_V(n) asm volatile("s_waitcnt vmcnt(" #n ")" ::: "memory")
#define PG8_WAIT_L(n) asm volatile("s_waitcnt lgkmcnt(" #n ")" ::: "memory")
#define PG8_BAR __builtin_amdgcn_s_barrier()
#define PG8_SCHED __builtin_amdgcn_sched_barrier(0)
    f32x4 acc[2][2][4][2];
#pragma unroll
    for (int a = 0; a < 2; ++a)
#pragma unroll
        for (int b = 0; b < 2; ++b)
#pragma unroll
            for (int m = 0; m < 4; ++m)
#pragma unroll
                for (int n = 0; n < 2; ++n) acc[a][b][m][n] = (f32x4){0.f, 0.f, 0.f, 0.f};
    int scw = SCALE_W, scx = SCALE_X; asm volatile("" : "+v"(scw), "+v"(scx));
    bf16x8 At[4][2], B0[2][2], B1[2][2]; v8i_ At8[4], B08[2], B18[2];
    const __amdgpu_buffer_rsrc_t rA = __builtin_amdgcn_make_buffer_rsrc((void*)Abase, 0, 0xffffffff, 0x00020000), rB = __builtin_amdgcn_make_buffer_rsrc((void*)S.bt_root(), 0, 0xffffffff, 0x00020000);
    int cA, cB = S.bt_off(cur) + cur.pn * tstep;
    if constexpr (Sched::GATHER) {
        cA = 0;
#pragma unroll
        for (int h = 0; h < 2; ++h)
#pragma unroll
            for (int i = 0; i < 2; ++i) { int R, C; stage_rc(tid * 16 + i * 8192, R, C); vA[h][i] = (unsigned)(S.row_src(cur, h * HALF + R) * rowb + C * 2); vN[h][i] = has_next ? (unsigned)(S.row_src(nxt, h * HALF + R) * rowb + C * 2) : vA[h][i]; }
    } else cA = cur.pm * tstep + (cur.hm > 0 ? hstep : 0);
    asm volatile("" : "+v"(voffB[0]), "+v"(voffB[1]), "+v"(vA[0][0]), "+v"(vA[0][1]), "+v"(vA[1][0]), "+v"(vA[1][1]));
    if constexpr (SP2) {
        PG8_STAGE(PG8_SB(0, 0), rB, cB, voffB); PG8_STAGE(PG8_SB(0, 1), rB, cB + hstep, voffB); PG8_STAGE(PG8_SA(0, 0), rA, cA, vA[0]); PG8_STAGE(PG8_SA(0, 1), rA, cA + hA, vA[1]);
        if (wr == 1) PG8_BAR;
        PG8_WAIT_V(2); PG8_BAR;
        PG8_STAGE(PG8_SB(1, 0), rB, cB + kstep, voffB); PG8_STAGE(PG8_SA(1, 0), rA, cA + kstep, vA[0]); PG8_STAGE(PG8_SB(1, 1), rB, cB + hstep + kstep, voffB);
        PG8_WAIT_V(6); PG8_BAR;
    } else {
        PG8_STAGE(PG8_SB(0, 0), rB, cB, voffB); PG8_STAGE(PG8_SA(0, 0), rA, cA, vA[0]); PG8_STAGE(PG8_SB(0, 1), rB, cB + hstep, voffB); PG8_STAGE(PG8_SA(0, 1), rA, cA + hA, vA[1]);
        if (wr == 1) PG8_BAR;
        PG8_WAIT_V(4); PG8_BAR;
        PG8_STAGE(PG8_SB(1, 0), rB, cB + kstep, voffB); PG8_STAGE(PG8_SA(1, 0), rA, cA + kstep, vA[0]); PG8_STAGE(PG8_SB(1, 1), rB, cB + hstep + kstep, voffB);
        PG8_WAIT_V(6); PG8_BAR;
    }
    for (;;) {
        int nA; const int nB = has_next ? S.bt_off(nxt) + nxt.pn * tstep : cB;
        if constexpr (Sched::GATHER) nA = cA; else nA = has_next ? nxt.pm * tstep + (nxt.hm > 0 ? hstep : 0) : cA;
        const bool whole = cur.hm < 0;
#pragma clang loop unroll(disable)
        for (int t = 0; t < nt; t += 2) {
            const bool last = (t == nt - 2);
            const int a1 = cA + (t + 1) * kstep;
            const int a2 = last ? nA : cA + (t + 2) * kstep; const int b2 = last ? nB : cB + (t + 2) * kstep;
            const int a3 = a2 + kstep; const int b3 = b2 + kstep;
            unsigned v2[2][2];
#pragma unroll
            for (int h = 0; h < 2; ++h)
#pragma unroll
                for (int i = 0; i < 2; ++i) v2[h][i] = (Sched::GATHER && last) ? vN[h][i] : vA[h][i];
            if constexpr (SP2) {
            PG8_LDB(B0, 0, 0); PG8_LDB(B1, 0, 1); PG8_SCHED; PG8_LDA(At, 0, 0); PG8_STAGE(PG8_SA(1, 1), rA, a1 + hA, vA[1]);
            PG8_WAIT_V(8); PG8_WAIT_L(0); PG8_BAR; PG8_MMA(0, 0, At, B0); PG8_MMA(0, 1, At, B1); PG8_BAR; PG8_SCHED;
            PG8_LDA(At, 0, 1); PG8_STAGE(PG8_SB(0, 0), rB, b2, voffB); PG8_STAGE(PG8_SB(0, 1), rB, b2 + hstep, voffB); PG8_STAGE(PG8_SA(0, 0), rA, a2, v2[0]);
            PG8_WAIT_V(8); PG8_WAIT_L(0); PG8_BAR; if (whole) { PG8_MMA(1, 0, At, B0); PG8_MMA(1, 1, At, B1); } PG8_BAR; PG8_SCHED;
            PG8_LDB(B0, 1, 0); PG8_LDB(B1, 1, 1); PG8_SCHED; PG8_LDA(At, 1, 0); PG8_STAGE(PG8_SA(0, 1), rA, a2 + hA, v2[1]);
            PG8_WAIT_V(8); PG8_WAIT_L(0); PG8_BAR; PG8_MMA(0, 0, At, B0); PG8_MMA(0, 1, At, B1); PG8_BAR; PG8_SCHED;
            PG8_LDA(At, 1, 1); PG8_STAGE(PG8_SB(1, 0), rB, b3, voffB); PG8_STAGE(PG8_SB(1, 1), rB, b3 + hstep, voffB); PG8_STAGE(PG8_SA(1, 0), rA, a3, v2[0]);
            PG8_WAIT_V(8); PG8_WAIT_L(0); PG8_BAR; if (whole) { PG8_MMA(1, 0, At, B0); PG8_MMA(1, 1, At, B1); } PG8_BAR; PG8_SCHED;
            } else {
            PG8_LDB(B0, 0, 0); PG8_SCHED; PG8_LDA(At, 0, 0); PG8_STAGE(PG8_SA(1, 1), rA, a1 + hA, vA[1]);
            PG8_WAIT_L(8); PG8_BAR; PG8_WAIT_L(0); PG8_MMA(0, 0, At, B0); PG8_BAR; PG8_SCHED;
            PG8_LDB(B1, 0, 1); PG8_STAGE(PG8_SB(0, 0), rB, b2, voffB);
            PG8_BAR; PG8_WAIT_L(0); PG8_MMA(0, 1, At, B1); PG8_BAR;
            PG8_LDA(At, 0, 1); PG8_STAGE(PG8_SA(0, 0), rA, a2, v2[0]);
            PG8_BAR; PG8_WAIT_L(0); PG8_MMA(1, 0, At, B0); PG8_BAR; PG8_SCHED;
            PG8_STAGE(PG8_SB(0, 1), rB, b2 + hstep, voffB);
            PG8_WAIT_V(6); PG8_BAR; PG8_MMA(1, 1, At, B1); PG8_BAR;
            PG8_LDB(B0, 1, 0); PG8_SCHED; PG8_LDA(At, 1, 0); PG8_STAGE(PG8_SA(0, 1), rA, a2 + hA, v2[1]);
            PG8_WAIT_L(8); PG8_BAR; PG8_WAIT_L(0); PG8_MMA(0, 0, At, B0); PG8_BAR; PG8_SCHED;
            PG8_LDB(B1, 1, 1); PG8_STAGE(PG8_SB(1, 0), rB, b3, voffB);
            PG8_BAR; PG8_WAIT_L(0); PG8_MMA(0, 1, At, B1); PG8_BAR;
            PG8_LDA(At, 1, 1); PG8_STAGE(PG8_SA(1, 0), rA, a3, v2[0]);
            PG8_BAR; PG8_WAIT_L(0); PG8_MMA(1, 0, At, B0); PG8_BAR; PG8_SCHED;
            PG8_STAGE(PG8_SB(1, 1), rB, b3 + hstep, voffB);
            PG8_WAIT_V(6); PG8_BAR; PG8_MMA(1, 1, At, B1); PG8_BAR;
            }
        }
        if constexpr (ALIGN_EPI) { if (wr == 0) PG8_BAR; }
        if constexpr (FP8) asm volatile("s_nop 15\n\ts_nop 15" ::: "memory");
        const int tid2 = opaque_tid(), lane2 = tid2 & 63;
        typename Epi::Prep pr; if (has_next) pr = E.prep_load(nxt, tid2);
        E(acc, cur, tab + (ui & 1) * 512, wr, wc, lane2 & 15, lane2 >> 4);
        if (!has_next) break;
        E.prep_store(pr, tab, (ui + 1) & 1, tid2); __builtin_amdgcn_sched_barrier(0);
#pragma unroll
        for (int a = 0; a < 2; ++a)
#pragma unroll
            for (int b = 0; b < 2; ++b)
#pragma unroll
                for (int m = 0; m < 4; ++m)
#pragma unroll
                    for (int n = 0; n < 2; ++n) acc[a][b][m][n] = (f32x4){0.f, 0.f, 0.f, 0.f};
        Unit nn; const bool has2 = S.next(ui + 2, nn);
        if constexpr (Sched::GATHER) {
#pragma unroll
            for (int h = 0; h < 2; ++h)
#pragma unroll
                for (int i = 0; i < 2; ++i) { int R, C; stage_rc(tid2 * 16 + i * 8192, R, C); const unsigned tnew = has2 ? (unsigned)(S.row_src(nn, h * HALF + R) * rowb + C * 2) : vN[h][i]; vA[h][i] = vN[h][i]; vN[h][i] = tnew; }
        }
        cur = nxt; nxt = nn; has_next = has2; cA = nA; cB = nB; ++ui;
        if constexpr (ALIGN_EPI) { if (wr == 1) PG8_BAR; }
    }
    PG8_WAIT_V(0);
    if constexpr (!ALIGN_EPI) { if (wr == 0) PG8_BAR; }
    PG8_BAR;
#undef PG8_SA
#undef PG8_SB
#undef PG8_STAGE
#undef PG8_LDA
#undef PG8_LDB
#undef PG8_MMA
#undef PG8_WAIT_V
#undef PG8_WAIT_L
#undef PG8_BAR
#undef PG8_SCHED
}
}
namespace pg8 {
__device__ __forceinline__ float silu_fast(float x) { return x * __builtin_amdgcn_rcpf(1.f + __expf(-x)); }
__device__ __forceinline__ float sigm_fast(float x) { return __builtin_amdgcn_rcpf(1.f + __expf(-x)); }
__device__ __forceinline__ f32x4 silu4(const f32x4 v) { f32x4 o; o[0] = silu_fast(v[0]); o[1] = silu_fast(v[1]); o[2] = silu_fast(v[2]); o[3] = silu_fast(v[3]); return o; }
__device__ __forceinline__ f32x4 sigm4(const f32x4 v) { f32x4 o; o[0] = sigm_fast(v[0]); o[1] = sigm_fast(v[1]); o[2] = sigm_fast(v[2]); o[3] = sigm_fast(v[3]); return o; }
__device__ __forceinline__ unsigned long long pack8_fp8(const f32x4 a, const f32x4 b) { int lo = 0, hi = 0; lo = __builtin_amdgcn_cvt_pk_fp8_f32(a[0], a[1], lo, false); lo = __builtin_amdgcn_cvt_pk_fp8_f32(a[2], a[3], lo, true);
    hi = __builtin_amdgcn_cvt_pk_fp8_f32(b[0], b[1], hi, false); hi = __builtin_amdgcn_cvt_pk_fp8_f32(b[2], b[3], hi, true); return (unsigned long long)(unsigned)lo | ((unsigned long long)(unsigned)hi << 32); }
__device__ __forceinline__ float logsig_fast(float x) { return fminf(x, 0.f) - __logf(1.f + __expf(-fabsf(x))); }
struct PrepNone { };
struct Prep2 { float a, b; };
struct EpiIn {
    static constexpr bool PERM = true; typedef Prep2 Prep;
    const float* ssq; const float* b_gate; bf16 *QS, *KB, *VB, *SG, *UB; float* LA;
    __device__ __forceinline__ Prep prep_load(const Unit& u, int tid) const { Prep p; p.b = 0.f; p.a = row_rstd(ssq, u.pm * BM + (u.hm > 0 ? HALF : 0) + (tid & 255)); return p; }
    __device__ __forceinline__ void prep_store(const Prep& p, PG8_LAS float* tab, int par, int tid) const { tab[par * 512 + (tid & 255)] = p.a; }
    __device__ __forceinline__ void operator()(const f32x4 (&acc)[2][2][4][2], const Unit& u, const PG8_LAS float* tb, int wr, int wc, int fr, int fq) const {
        const int tile = u.pn, cin = wc * 32 + 8 * fq, rb0 = u.pm * BM + (u.hm > 0 ? HALF : 0);
        f32x4 bg[2][2];
        if (tile == 6) {
#pragma unroll
            for (int bj = 0; bj < 2; ++bj)
#pragma unroll
                for (int n = 0; n < 2; ++n) bg[bj][n] = *(const f32x4*)(b_gate + bj * 128 + cin + 4 * n);
        }
#pragma unroll
        for (int ai = 0; ai < 2; ++ai) if (ai == 0 || u.hm < 0)
#pragma unroll
            for (int m = 0; m < 4; ++m) {
                const int lr = ai * HALF + wr * 64 + m * 16 + fr, row = rb0 + lr; const float r = tb[lr];
                const f32x4 l0 = acc[ai][0][m][0] * r, l1 = acc[ai][0][m][1] * r, h0 = acc[ai][1][m][0] * r, h1 = acc[ai][1][m][1] * r;
                if (tile == 0) { bf16* p = QS + (size_t)row * KEY + cin; *(u32x4*)p = pack8(l0 * 0.125f, l1 * 0.125f); *(u32x4*)(p + 128) = pack8(h0 * 0.125f, h1 * 0.125f); }
                else if (tile == 1) { bf16* p = KB + (size_t)row * KEY + cin; *(u32x4*)p = pack8(l0, l1); *(u32x4*)(p + 128) = pack8(h0, h1); }
                else if (tile < 4) { bf16* p = VB + (size_t)row * VAL + (tile - 2) * 256 + cin; *(u32x4*)p = pack8(l0, l1); *(u32x4*)(p + 128) = pack8(h0, h1); }
                else if (tile < 6) { bf16* p = SG + (size_t)row * VAL + (tile - 4) * 256 + cin; *(u32x4*)p = pack8(silu4(l0), silu4(l1)); *(u32x4*)(p + 128) = pack8(silu4(h0), silu4(h1)); }
                else if (tile == 6) { float* p = LA + (size_t)row * KEY + cin; f32x4 o;
#pragma unroll
                    for (int j = 0; j < 4; ++j) o[j] = logsig_fast(l0[j] + bg[0][0][j]) * 0.0625f; *(f32x4*)p = o;
#pragma unroll
                    for (int j = 0; j < 4; ++j) o[j] = logsig_fast(l1[j] + bg[0][1][j]) * 0.0625f; *(f32x4*)(p + 4) = o;
#pragma unroll
                    for (int j = 0; j < 4; ++j) o[j] = logsig_fast(h0[j] + bg[1][0][j]) * 0.0625f; *(f32x4*)(p + 128) = o;
#pragma unroll
                    for (int j = 0; j < 4; ++j) o[j] = logsig_fast(h1[j] + bg[1][1][j]) * 0.0625f; *(f32x4*)(p + 132) = o; }
                else { bf16* p = UB + (size_t)row * CCH + (tile - 7) * 128 + cin; *(u32x4*)p = pack8(l0 * sigm4(h0), l1 * sigm4(h1)); }
            }
    }
};
struct EpiRes {
    static constexpr bool PERM = true; typedef PrepNone Prep;
    bf16* XB; float* SSQ; unsigned char* X8;
    __device__ __forceinline__ Prep prep_load(const Unit&, int) const { return Prep(); }
    __device__ __forceinline__ void prep_store(const Prep&, PG8_LAS float*, int, int) const {}
    __device__ __forceinline__ void operator()(const f32x4 (&acc)[2][2][4][2], const Unit& u, const PG8_LAS float*, int wr, int wc, int fr, int fq) const {
        const int cin = wc * 32 + 8 * fq, rb0 = u.pm * BM + (u.hm > 0 ? HALF : 0); (void)rb0;
#pragma unroll
        for (int ai = 0; ai < 2; ++ai) if (ai == 0 || u.hm < 0) {
            u32x4 rv[4][2];
#pragma unroll
            for (int m = 0; m < 4; ++m) { const size_t o = (size_t)(rb0 + ai * HALF + wr * 64 + m * 16 + fr) * D + u.pn * BM + cin;
#pragma unroll
                for (int bj = 0; bj < 2; ++bj) rv[m][bj] = *(const u32x4*)(XB + o + bj * HALF); }
#pragma unroll
            for (int m = 0; m < 4; ++m) {
                const int row = rb0 + ai * HALF + wr * 64 + m * 16 + fr; const size_t o = (size_t)row * D + u.pn * BM + cin; float ss = 0.f;
#pragma unroll
                for (int bj = 0; bj < 2; ++bj) { const u32x4 r = rv[m][bj];
                    const f32x4 x0 = (f32x4){__uint_as_float(r.x << 16), __uint_as_float(r.x & 0xffff0000u), __uint_as_float(r.y << 16), __uint_as_float(r.y & 0xffff0000u)} + acc[ai][bj][m][0];
                    const f32x4 x1 = (f32x4){__uint_as_float(r.z << 16), __uint_as_float(r.z & 0xffff0000u), __uint_as_float(r.w << 16), __uint_as_float(r.w & 0xffff0000u)} + acc[ai][bj][m][1];
                    *(u32x4*)(XB + o + bj * HALF) = pack8(x0, x1);
                    if (X8) *(unsigned long long*)(X8 + o + bj * HALF) = pack8_fp8(x0, x1);
                    ss += (x0[0] * x0[0] + x0[1] * x0[1]) + (x0[2] * x0[2] + x0[3] * x0[3]) + (x1[0] * x1[0] + x1[1] * x1[1]) + (x1[2] * x1[2] + x1[3] * x1[3]); }
                ss += __shfl_xor(ss, 16); ss += __shfl_xor(ss, 32);
                if (fq == 0) SSQ[(size_t)row * 16 + u.pn * 4 + wc] = ss;
            }
            asm volatile("" ::: "memory");
        }
    }
};
struct EpiUp {
    static constexpr bool PERM = true; typedef Prep2 Prep;
    const float* ssq; bf16* ACT;
    __device__ __forceinline__ Prep prep_load(const Unit& u, int tid) const { Prep p; p.b = 0.f; p.a = row_rstd(ssq, u.pm * BM + (u.hm > 0 ? HALF : 0) + (tid & 255)); return p; }
    __device__ __forceinline__ void prep_store(const Prep& p, PG8_LAS float* tab, int par, int tid) const { tab[par * 512 + (tid & 255)] = p.a; }
    __device__ __forceinline__ void operator()(const f32x4 (&acc)[2][2][4][2], const Unit& u, const PG8_LAS float* tb, int wr, int wc, int fr, int fq) const {
        const int cin = wc * 32 + 8 * fq, rb0 = u.pm * BM + (u.hm > 0 ? HALF : 0); (void)rb0;
#pragma unroll
        for (int ai = 0; ai < 2; ++ai) if (ai == 0 || u.hm < 0)
#pragma unroll
            for (int m = 0; m < 4; ++m) {
                const int lr = ai * HALF + wr * 64 + m * 16 + fr, row = rb0 + lr; const float r = tb[lr];
                const f32x4 g0 = silu4(acc[ai][0][m][0] * r), g1 = silu4(acc[ai][0][m][1] * r);
                *(u32x4*)(ACT + (size_t)row * FF + u.pn * 128 + cin) = pack8(g0 * (acc[ai][1][m][0] * r), g1 * (acc[ai][1][m][1] * r));
            }
    }
};
struct EpiUpMoe {
    static constexpr bool PERM = true; typedef Prep2 Prep;
    const float* ssq; const int* rowinfo; const float* rowg; unsigned char* ACT;
    __device__ __forceinline__ Prep prep_load(const Unit& u, int tid) const { Prep p; p.a = 0.f; p.b = 0.f;
        { const int row = u.pm * BM + (u.hm > 0 ? HALF : 0) + (tid & 255); const int tok = rowinfo[row] & 0x3fff; p.a = row_rstd(ssq, tok); p.b = rowg[row] * p.a * 16.f; } return p; }
    __device__ __forceinline__ void prep_store(const Prep& p, PG8_LAS float* tab, int par, int tid) const { tab[par * 512 + (tid & 255)] = p.a; tab[par * 512 + 256 + (tid & 255)] = p.b; }
    __device__ __forceinline__ void operator()(const f32x4 (&acc)[2][2][4][2], const Unit& u, const PG8_LAS float* tb, int wr, int wc, int fr, int fq) const {
        const int cin = wc * 32 + 8 * fq, rb0 = u.pm * BM + (u.hm > 0 ? HALF : 0); (void)rb0;
#pragma unroll
        for (int ai = 0; ai < 2; ++ai) if (ai == 0 || u.hm < 0)
#pragma unroll
            for (int m = 0; m < 4; ++m) {
                const int lr = ai * HALF + wr * 64 + m * 16 + fr, row = rb0 + lr; const float r = tb[lr], gw = tb[256 + lr];
                const f32x4 g0 = silu4(acc[ai][0][m][0] * r), g1 = silu4(acc[ai][0][m][1] * r);
                *(unsigned long long*)(ACT + (size_t)row * FF + u.pn * 128 + cin) = pack8_fp8(g0 * (acc[ai][1][m][0] * gw), g1 * (acc[ai][1][m][1] * gw));
            }
    }
};
struct EpiDownMoe {
    static constexpr bool PERM = true; typedef Prep2 Prep;
    const int* rowinfo; bf16* YY;
    __device__ __forceinline__ Prep prep_load(const Unit& u, int tid) const { Prep p; p.b = 0.f; p.a = __int_as_float(rowinfo[u.pm * BM + (u.hm > 0 ? HALF : 0) + (tid & 255)]); return p; }
    __device__ __forceinline__ void prep_store(const Prep& p, PG8_LAS float* tab, int par, int tid) const { tab[par * 512 + (tid & 255)] = p.a; }
    __device__ __forceinline__ void operator()(const f32x4 (&acc)[2][2][4][2], const Unit& u, const PG8_LAS float* tb, int wr, int wc, int fr, int fq) const {
        const int cin = wc * 32 + 8 * fq, rb0 = u.pm * BM + (u.hm > 0 ? HALF : 0); (void)rb0;
#pragma unroll
        for (int ai = 0; ai < 2; ++ai) if (ai == 0 || u.hm < 0)
#pragma unroll
            for (int m = 0; m < 4; ++m) {
                const int lr = ai * HALF + wr * 64 + m * 16 + fr; const int info = __float_as_int(tb[lr]);
                if (info & 0x8000) { bf16* p = YY + (size_t)(info & 0x3fff) * 2048 + ((info >> 14) & 1) * 1024 + u.pn * BM + cin;
#pragma unroll
                    for (int bj = 0; bj < 2; ++bj) *(u32x4*)(p + bj * HALF) = pack8(acc[ai][bj][m][0], acc[ai][bj][m][1]); }
            }
    }
};
}

#define XB_TMO      128
#define XB_XCNT(j)  (256  + 64 * (j))
#define XB_XSUB(j)  (1280 + 64 * (j))
#define XB_XGEN(j)  (2304 + 64 * (j))
#define XB_TOP      3328
#define XB_TOPGEN   3392
#define XCD_BAR_WORDS 3456
#define XB_SPIN_CAP (1u << 18)
__device__ __forceinline__ unsigned xb_ld(unsigned* p)              { return __hip_atomic_load(p, __ATOMIC_RELAXED, __HIP_MEMORY_SCOPE_AGENT); }
__device__ __forceinline__ unsigned xb_add(unsigned* p, unsigned v) { return __hip_atomic_fetch_add(p, v, __ATOMIC_RELAXED, __HIP_MEMORY_SCOPE_AGENT); }
__device__ __forceinline__ unsigned xb_xcc_id() { return (unsigned)__builtin_amdgcn_s_getreg((3 << 11) | 20) & 0xFu; }
#define XB_SPIN(cond, bar) do { unsigned _sp = 0; while (cond) { __builtin_amdgcn_s_sleep(1); \
    if ((++_sp & 255u) == 0u) { if (xb_ld(&(bar)[XB_TMO])) break; if (_sp > XB_SPIN_CAP) { atomicAdd(&(bar)[XB_TMO], 1u); break; } } } } while (0)
struct XcdBarrier { unsigned* bar; unsigned x; volatile LAS unsigned* st; };
__device__ __forceinline__ XcdBarrier xcd_barrier_post(unsigned* bar, volatile LAS unsigned* st) {
    XcdBarrier b; b.bar = bar; b.x = xb_xcc_id(); b.st = st;
    if (threadIdx.x == 0) (void)xb_add(&bar[XB_XCNT(b.x)], 1u);
    return b;
}
__device__ __forceinline__ void xcd_barrier_complete(unsigned* bar, unsigned x, unsigned& nloc, unsigned& nx) {
    const unsigned G = gridDim.x * gridDim.y * gridDim.z;
    unsigned sum, cnt, mine, sp = 0u;
    for (;;) {
        sum = 0u; cnt = 0u; mine = 0u;
#pragma unroll
        for (unsigned j = 0; j < 16; ++j) { const unsigned c = xb_ld(&bar[XB_XCNT(j)]); sum += c; cnt += (c > 0u) ? 1u : 0u; mine = (j == x) ? c : mine; }
        if (sum == G) break;
        __builtin_amdgcn_s_sleep(1);
        if ((++sp & 255u) == 0u) { if (xb_ld(&bar[XB_TMO])) break; if (sp > XB_SPIN_CAP) { atomicAdd(&bar[XB_TMO], 1u); break; } }
    }
    nloc = mine > 0u ? mine : 1u; nx = cnt > 0u ? cnt : 1u;
}
__device__ __forceinline__ void xcd_barrier(const XcdBarrier& b) {
    asm volatile("s_waitcnt vmcnt(0)" ::: "memory");
    __syncthreads();
    if (threadIdx.x == 0) {
        unsigned* bar = b.bar;
        __builtin_amdgcn_s_waitcnt(0);
        unsigned nloc = b.st[0], nx = b.st[1];
        if (nloc == 0u) { xcd_barrier_complete(bar, b.x, nloc, nx); b.st[0] = nloc; b.st[1] = nx; }
        const unsigned old = xb_add(&bar[XB_XSUB(b.x)], 1u);
        const unsigned gen = old / nloc;
        if (old + 1u == (gen + 1u) * nloc) {
            __builtin_amdgcn_fence(__ATOMIC_RELEASE, "agent");
            asm volatile("s_waitcnt vmcnt(0)" ::: "memory");
            const unsigned og = xb_add(&bar[XB_TOP], 1u);
            const unsigned tg = og / nx;
            if (og + 1u == (tg + 1u) * nx) xb_add(&bar[XB_TOPGEN], 1u);
            else XB_SPIN(xb_ld(&bar[XB_TOPGEN]) == tg, bar);
            __builtin_amdgcn_fence(__ATOMIC_ACQUIRE, "agent");
            xb_add(&bar[XB_XGEN(b.x)], 1u);
            asm volatile("s_waitcnt vmcnt(0)" ::: "memory");
        } else {
            XB_SPIN(xb_ld(&bar[XB_XGEN(b.x)]) == gen, bar);
            __builtin_amdgcn_fence(__ATOMIC_ACQUIRE, "agent");
            asm volatile("s_waitcnt vmcnt(0)" ::: "memory");
        }
    }
    __syncthreads();
}

constexpr int NWAVES = 8, NTHR = 512;
constexpr int RING_BYTES = 131072, MISC_OFF = RING_BYTES, LDS_BYTES = 147456;
constexpr size_t MI_CNT = 1024 * 1024, MI_ROWINFO = 1040 * 1024, MI_ROWG = 1184 * 1024, MI_TILEE = 1328 * 1024;
constexpr int MAXTILES = 136;
constexpr size_t WS_ACTM = WS_WIN0;
constexpr size_t WS_Y1 = WS_XB;
static_assert(WS_ACTM + (size_t)MAXTILES * 256 * FF * 2 <= WS_END, "ACTM fits");

typedef short bf16x8 __attribute__((ext_vector_type(8)));

struct GlaIn { v4u qv, kv, vv[2]; f32x4 lv[2]; };
__device__ __forceinline__ void gla_chunk_load(int g, GlaIn& in, const bf16* QSg, const bf16* KBg, const bf16* VBg, const float* LAg) {
    const int tid = opaque_tid(); const int bh = g >> 6, n = g & 63, b = bh >> 2, h = bh & 3; const size_t row0 = (size_t)b * T + n * CHUNK;
    const int r = tid >> 3, s8 = (tid & 7) * 8; const size_t go = (row0 + r) * KEY + h * 64 + s8;
    in.qv = *(const v4u*)(QSg + go); in.kv = *(const v4u*)(KBg + go);
#pragma unroll
    for (int k = 0; k < 2; ++k) { const int e = tid + 512 * k, rr = e >> 4; in.lv[k] = *(const f32x4*)(LAg + (row0 + rr) * KEY + h * 64 + (e & 15) * 4); in.vv[k] = *(const v4u*)(VBg + (row0 + rr) * VAL + h * 128 + (e & 15) * 8); }
}
__device__ __forceinline__ void gla_chunk_unit(int g, const GlaIn& in, LAS unsigned char* lds, bf16* QTg, bf16* OIg, float* DSg, float* DECg) {
    const int tid = opaque_tid(), lane = tid & 63, wid = __builtin_amdgcn_readfirstlane(tid >> 6);
    const int bh = g >> 6, n = g & 63, b = bh >> 2, h = bh & 3; const size_t row0 = (size_t)b * T + n * CHUNK;
    LAS float* LAf = (LAS float*)lds; LAS bf16* Qr = (LAS bf16*)(lds + 16384); LAS bf16* Kr = (LAS bf16*)(lds + 25600); LAS bf16* Vr = (LAS bf16*)(lds + 34816); LAS float* SEG = (LAS float*)(lds + 52224);
    LAS bf16* QTl = (LAS bf16*)(lds + 54272); LAS bf16* KTl = (LAS bf16*)(lds + 63488); LAS bf16* KHT = (LAS bf16*)(lds + 72704); LAS bf16* VT = (LAS bf16*)(lds + 81920); LAS bf16* P = (LAS bf16*)(lds + 100352);
    { const int r = tid >> 3, s8 = (tid & 7) * 8;
      *(LAS v4u*)(Qr + r * 72 + s8) = in.qv; *(LAS v4u*)(Kr + r * 72 + s8) = in.kv;
#pragma unroll
      for (int k = 0; k < 2; ++k) { const int e = tid + 512 * k, rr = e >> 4; *(LAS f32x4*)(LAf + rr * 64 + (e & 15) * 4) = in.lv[k]; *(LAS v4u*)(Vr + rr * 136 + (e & 15) * 8) = in.vv[k]; } }
    __syncthreads();
    const int d = lane, seg = wid;
    float c[8];
    { float run = 0.f;
#pragma unroll
      for (int i = 0; i < 8; ++i) { run += LAf[(seg * 8 + i) * 64 + d]; c[i] = run; }
      SEG[seg * 64 + d] = run; }
    { const int v = tid & 127, jg = tid >> 7; unsigned w[8];
#pragma unroll
      for (int i = 0; i < 8; ++i) w[i] = (unsigned)Vr[(jg * 16 + 2 * i) * 136 + v] | ((unsigned)Vr[(jg * 16 + 2 * i + 1) * 136 + v] << 16);
      *(LAS v4u*)(VT + v * 72 + jg * 16) = (v4u){w[0], w[1], w[2], w[3]}; *(LAS v4u*)(VT + v * 72 + jg * 16 + 8) = (v4u){w[4], w[5], w[6], w[7]}; }
    __syncthreads();
    { float off = 0.f, tot = 0.f;
#pragma unroll
      for (int s2 = 0; s2 < 8; ++s2) { const float v = SEG[s2 * 64 + d]; tot += v; off += (s2 < seg) ? v : 0.f; }
      if (seg == 0) DECg[(size_t)g * 64 + d] = __expf(tot);
      unsigned kh[4];
#pragma unroll
      for (int i = 0; i < 8; ++i) { const int ii = seg * 8 + i; const float bb = off + c[i]; const float qv = bf2f(Qr[ii * 72 + d]), kv = bf2f(Kr[ii * 72 + d]);
          QTl[ii * 72 + d] = (bf16)f2bf(qv * __expf(bb)); KTl[ii * 72 + d] = (bf16)f2bf(kv * __expf(-bb));
          const unsigned hv = f2bf(kv * __expf(tot - bb)); if (i & 1) kh[i >> 1] |= hv << 16; else kh[i >> 1] = hv; }
      *(LAS v4u*)(KHT + d * 72 + seg * 8) = (v4u){kh[0], kh[1], kh[2], kh[3]}; }
    __syncthreads();
    { const int r = tid >> 3, s8 = (tid & 7) * 8; *(v4u*)(QTg + (row0 + r) * KEY + h * 64 + s8) = *(const LAS v4u*)(QTl + r * 72 + s8); }
    const int fr = lane & 15, fq = lane >> 4;
    { const int it = wid >> 1;
      const bf16x8 qb0 = *(const LAS bf16x8*)(QTl + (it * 16 + fr) * 72 + fq * 8), qb1 = *(const LAS bf16x8*)(QTl + (it * 16 + fr) * 72 + 32 + fq * 8);
#pragma unroll
      for (int jj = 0; jj < 2; ++jj) { const int jt = 2 * (wid & 1) + jj;
          const bf16x8 ka0 = *(const LAS bf16x8*)(KTl + (jt * 16 + fr) * 72 + fq * 8), ka1 = *(const LAS bf16x8*)(KTl + (jt * 16 + fr) * 72 + 32 + fq * 8);
          f32x4 a = (f32x4){0.f, 0.f, 0.f, 0.f};
          a = __builtin_amdgcn_mfma_f32_16x16x32_bf16(ka0, qb0, a, 0, 0, 0); a = __builtin_amdgcn_mfma_f32_16x16x32_bf16(ka1, qb1, a, 0, 0, 0);
          const int i = it * 16 + fr, j0 = jt * 16 + 4 * fq;
          unsigned long long w = 0ull;
#pragma unroll
          for (int r = 0; r < 4; ++r) { const float v = (j0 + r <= i) ? a[r] : 0.f; w |= (unsigned long long)f2bf(v) << (16 * r); }
          *(LAS unsigned long long*)(P + i * 72 + j0) = w; } }
    __syncthreads();
    { const int xt = wid & 3;
      const bf16x8 pb0 = *(const LAS bf16x8*)(P + (xt * 16 + fr) * 72 + fq * 8), pb1 = *(const LAS bf16x8*)(P + (xt * 16 + fr) * 72 + 32 + fq * 8);
      const bf16x8 ha0 = *(const LAS bf16x8*)(KHT + (xt * 16 + fr) * 72 + fq * 8), ha1 = *(const LAS bf16x8*)(KHT + (xt * 16 + fr) * 72 + 32 + fq * 8);
#pragma unroll
      for (int vv = 0; vv < 4; ++vv) { const int vt = 4 * (wid >> 2) + vv;
          const bf16x8 va0 = *(const LAS bf16x8*)(VT + (vt * 16 + fr) * 72 + fq * 8), va1 = *(const LAS bf16x8*)(VT + (vt * 16 + fr) * 72 + 32 + fq * 8);
          f32x4 o = (f32x4){0.f, 0.f, 0.f, 0.f};
          o = __builtin_amdgcn_mfma_f32_16x16x32_bf16(va0, pb0, o, 0, 0, 0); o = __builtin_amdgcn_mfma_f32_16x16x32_bf16(va1, pb1, o, 0, 0, 0);
          *(unsigned long long*)(OIg + (row0 + xt * 16 + fr) * VAL + h * 128 + vt * 16 + 4 * fq) = (unsigned long long)pk2(o[0], o[1]) | ((unsigned long long)pk2(o[2], o[3]) << 32);
          f32x4 s = (f32x4){0.f, 0.f, 0.f, 0.f};
          s = __builtin_amdgcn_mfma_f32_16x16x32_bf16(ha0, va0, s, 0, 0, 0); s = __builtin_amdgcn_mfma_f32_16x16x32_bf16(ha1, va1, s, 0, 0, 0);
          *(f32x4*)(DSg + ((size_t)g * 128 + vt * 16 + fr) * 64 + xt * 16 + 4 * fq) = s; } }
    __syncthreads();
}

__device__ __forceinline__ void conv_unit(int cu, LAS unsigned char* lds, const bf16* UBg, const float* cw, const float* cb, const float* cnw, const float* cnb, bf16* MIXg) {
    const int tid = opaque_tid(), c = tid; const int row0 = cu * 32, t0 = row0 & (T - 1);
    LAS bf16* U = (LAS bf16*)lds; LAS float* Y = (LAS float*)(lds + 63488); LAS float* STAT = (LAS float*)(lds + 129536);
    { v4u uv[8];
#pragma unroll
      for (int k = 0; k < 8; ++k) { const int e = min(tid + 512 * k, 62 * 64 - 1), r = e >> 6; const bool ok = (t0 + r >= 30);
          uv[k] = *(const v4u*)(UBg + (size_t)(ok ? row0 - 30 + r : row0) * CCH + (e & 63) * 8); if (!ok) uv[k] = (v4u){0u, 0u, 0u, 0u}; }
#pragma unroll
      for (int k = 0; k < 8; ++k) { const int e = min(tid + 512 * k, 62 * 64 - 1); *(LAS v4u*)(U + (size_t)e * 8) = uv[k]; } }
    float w[CW];
#pragma unroll
    for (int k = 0; k < CW; ++k) w[k] = cw[k * CCH + c];
    float y[32]; const float bias = cb[c];
#pragma unroll
    for (int i = 0; i < 32; ++i) y[i] = bias;
    __syncthreads();
    float uu[62];
#pragma unroll
    for (int p = 0; p < 62; ++p) uu[p] = bf2f(U[p * 512 + c]);
#pragma clang loop unroll(full)
    for (int k = 0; k < CW; ++k) {
#pragma clang loop unroll(full)
        for (int i = 0; i < 32; ++i) y[i] = fmaf(uu[i + k], w[k], y[i]);
    }
#pragma unroll
    for (int i = 0; i < 32; ++i) Y[i * 516 + c] = y[i];
    __syncthreads();
    { const int tt = tid >> 4, part = tid & 15; float s = 0.f, q = 0.f;
#pragma unroll
      for (int k = 0; k < 32; ++k) { const float v = Y[tt * 516 + part * 32 + ((k + part) & 31)]; s += v; q += v * v; }
#pragma unroll
      for (int o = 1; o < 16; o <<= 1) { s += __shfl_xor(s, o); q += __shfl_xor(q, o); }
      if (part == 0) { const float mean = s * (1.f / CCH); const float var = fmaxf(q * (1.f / CCH) - mean * mean, 0.f); STAT[tt * 2] = mean; STAT[tt * 2 + 1] = rsqrtf(var + EPS); } }
    __syncthreads();
    const float gw = cnw[c], gb = cnb[c];
#pragma unroll
    for (int i = 0; i < 32; ++i) { const float z = (y[i] - STAT[i * 2]) * STAT[i * 2 + 1] * gw + gb; U[i * 512 + c] = (bf16)f2bf(z * __builtin_amdgcn_rcpf(1.f + __expf(-z))); }
    __syncthreads();
#pragma unroll
    for (int k = 0; k < 4; ++k) { const int e = tid + 512 * k, r = e >> 6; *(v4u*)(MIXg + (size_t)(row0 + r) * D + 512 + (e & 63) * 8) = *(const LAS v4u*)(U + (size_t)e * 8); }
    __syncthreads();
}

__device__ __forceinline__ void gla_out_unit(int g, LAS unsigned char* lds, const bf16* QTg, const bf16* SP, const bf16* OI, const bf16* SG, const float* gnw, bf16* MIX) {
    const int tid = opaque_tid(), lane = tid & 63, wid = __builtin_amdgcn_readfirstlane(tid >> 6);
    const int bh = g >> 6, n = g & 63, b = bh >> 2, h = bh & 3; const size_t row0 = (size_t)b * T + n * CHUNK;
    LAS bf16* QTl = (LAS bf16*)lds; LAS bf16* ST = (LAS bf16*)(lds + 9216); LAS float* SS = (LAS float*)(lds + 27648);
    { const int i = tid >> 3, ds = (tid & 7) * 8; *(LAS v4u*)(QTl + i * 72 + ds) = *(const v4u*)(QTg + (row0 + i) * KEY + h * 64 + ds); }
#pragma unroll
    for (int k = 0; k < 2; ++k) { const int e = tid + k * 512, v = e >> 3, ds = (e & 7) * 8; *(LAS v4u*)(ST + v * 72 + ds) = *(const v4u*)(SP + ((size_t)g * 128 + v) * 64 + ds); }
    __syncthreads();
    const int fr = lane & 15, fq = lane >> 4, it = wid & 3;
    const bf16x8 qb0 = *(const LAS bf16x8*)(QTl + (it * 16 + fr) * 72 + fq * 8), qb1 = *(const LAS bf16x8*)(QTl + (it * 16 + fr) * 72 + 32 + fq * 8);
    f32x4 o[4]; float ss = 0.f; const size_t rowi = row0 + it * 16 + fr; unsigned long long sgv[4]; f32x4 gwv[4];
#pragma unroll
    for (int vv = 0; vv < 4; ++vv) { const int v0 = (4 * (wid >> 2) + vv) * 16 + 4 * fq; sgv[vv] = *(const unsigned long long*)(SG + rowi * VAL + h * 128 + v0); gwv[vv] = *(const f32x4*)(gnw + v0); }
#pragma unroll
    for (int vv = 0; vv < 4; ++vv) { const int vt = 4 * (wid >> 2) + vv;
        const bf16x8 sa0 = *(const LAS bf16x8*)(ST + (vt * 16 + fr) * 72 + fq * 8), sa1 = *(const LAS bf16x8*)(ST + (vt * 16 + fr) * 72 + 32 + fq * 8);
        f32x4 a = (f32x4){0.f, 0.f, 0.f, 0.f};
        a = __builtin_amdgcn_mfma_f32_16x16x32_bf16(sa0, qb0, a, 0, 0, 0); a = __builtin_amdgcn_mfma_f32_16x16x32_bf16(sa1, qb1, a, 0, 0, 0);
        const unsigned long long oi = *(const unsigned long long*)(OI + rowi * VAL + h * 128 + vt * 16 + 4 * fq);
        a[0] += __uint_as_float((unsigned)(oi << 16)); a[1] += __uint_as_float((unsigned)oi & 0xffff0000u); a[2] += __uint_as_float((unsigned)(oi >> 32) << 16); a[3] += __uint_as_float((unsigned)(oi >> 32) & 0xffff0000u);
        o[vv] = a; ss += (a[0] * a[0] + a[1] * a[1]) + (a[2] * a[2] + a[3] * a[3]); }
    ss += __shfl_xor(ss, 16); ss += __shfl_xor(ss, 32);
    if (fq == 0) SS[(wid >> 2) * 64 + it * 16 + fr] = ss;
    __syncthreads();
    const float r = rsqrtf((SS[it * 16 + fr] + SS[64 + it * 16 + fr]) * (1.f / DV) + EPS);
#pragma unroll
    for (int vv = 0; vv < 4; ++vv) { const int v0 = (4 * (wid >> 2) + vv) * 16 + 4 * fq; const f32x4 gw = gwv[vv];
        const unsigned long long sg = sgv[vv];
        const float s0 = __uint_as_float((unsigned)(sg << 16)), s1 = __uint_as_float((unsigned)sg & 0xffff0000u), s2 = __uint_as_float((unsigned)(sg >> 32) << 16), s3 = __uint_as_float((unsigned)(sg >> 32) & 0xffff0000u);
        *(unsigned long long*)(MIX + rowi * D + h * 128 + v0) = (unsigned long long)pk2(o[vv][0] * r * gw[0] * s0, o[vv][1] * r * gw[1] * s1) | ((unsigned long long)pk2(o[vv][2] * r * gw[2] * s2, o[vv][3] * r * gw[3] * s3) << 32); }
    __syncthreads();
}

struct Args { Inputs I; float* out; unsigned char* ws; int ph_lo, ph_hi; };
__global__ void __launch_bounds__(NTHR, 2) mk_fwd(Args args) {
    extern __shared__ __attribute__((aligned(16))) unsigned char lds_raw[];
    LAS unsigned char* lds = (LAS unsigned char*)lds_raw;
    const int G = gridDim.x, bx = blockIdx.x;
#define PH_IDS const int tid = opaque_tid(), lane = tid & 63, wave = __builtin_amdgcn_readfirstlane(tid >> 6); (void)lane; (void)wave
    unsigned char* ws = args.ws; const Inputs& I = args.I; float* XA = args.out;
#define XB ((bf16*)(ws + WS_XB))
#define QS ((bf16*)(ws + WS_QS))
#define KB ((bf16*)(ws + WS_KB))
#define VB ((bf16*)(ws + WS_VB))
#define SG ((bf16*)(ws + WS_SG))
#define UB ((bf16*)(ws + WS_UB))
#define MIX ((bf16*)(ws + WS_MIX))
#define ACT ((bf16*)(ws + WS_ACT))
#define QT ((bf16*)(ws + WS_QT))
#define OI ((bf16*)(ws + WS_OI))
#define SP ((bf16*)(ws + WS_SP))
#define ACTM ((bf16*)(ws + WS_ACTM))
#define Y1 ((bf16*)(ws + WS_Y1))
#define SSQ ((float*)(ws + WS_SSQ))
#define LA ((float*)(ws + WS_LA))
#define DS ((float*)(ws + WS_DS))
#define DEC ((float*)(ws + WS_MISC + MI_DEC))
#define ROWG ((float*)(ws + WS_MISC + MI_ROWG))
#define SEL ((int*)(ws + WS_MISC + MI_SEL))
#define CNT ((int*)(ws + WS_MISC + MI_CNT))
#define ROWINFO ((int*)(ws + WS_MISC + MI_ROWINFO))
#define TILEE ((int*)(ws + WS_MISC + MI_TILEE))
    const int lo = args.ph_lo, hi = args.ph_hi;
    if (threadIdx.x < 4) ((LAS unsigned*)(lds + MISC_OFF))[threadIdx.x] = 0u;
    __syncthreads();
    XcdBarrier bar; bar.bar = (unsigned*)(ws + WS_CTL) + 4096; bar.x = 0; bar.st = nullptr;
    if (hi - lo > 1) bar = xcd_barrier_post((unsigned*)(ws + WS_CTL) + 4096, (volatile LAS unsigned*)(lds + MISC_OFF));
#ifndef PHMASK
#define PHMASK 0x3ffff
#endif
#define IN(k) (((PHMASK >> ((k) >= 8 && (k) <= 12 ? (k) - 7 : (k))) & 1) && lo <= (k) && (k) < hi)
#define SEAM(k) do { if (IN(k) && IN((k) + 1)) xcd_barrier(bar); } while (0)

    if (IN(0)) { PH_IDS;
        LAS float* scr = (LAS float*)(lds + wave * 16384); const int gw = bx * NWAVES + wave, NGW = G * NWAVES;
        cvt_all(I, ws, gw, NGW, scr, lane);
        for (int idx = bx * NTHR + tid; idx < 2 * 256 * 1024; idx += G * NTHR) cvt_gate_elem(I, ws, idx);
        for (int m = gw; m < M; m += NGW) row_to_xb(I.x + (size_t)m * D, XB + (size_t)m * D, SSQ + (size_t)m * 16, lane);
        __syncthreads();
    }
    SEAM(0);
    for (int l = 0; l < 2; ++l) {
        const int pb = 1 + 7 * l;
        const bf16* Win = (const bf16*)(ws + (l ? WS_WIN1 : WS_WIN0)); const bf16* Wout = (const bf16*)(ws + (l ? WS_WOUT1 : WS_WOUT0));
        if (IN(pb)) {
            pg8::StaticOrder<NIN / 256> S; S.init(M / 256, G, bx, Win);
            pg8::EpiIn E{SSQ, I.b_gate + l * KEY, QS, KB, VB, SG, UB, LA};
            pg8::gemm_phase<pg8::EpiIn, pg8::StaticOrder<NIN / 256>, true, true>(lds, (LAS float*)(lds + MISC_OFF + 64), XB, D, S, E);
        }
        SEAM(pb);
        if (IN(pb + 1)) {
            GlaIn gin; if (bx < 1024) gla_chunk_load(bx, gin, QS, KB, VB, LA);
            for (int u = bx; u < 1024 + 512; u += G) {
                if (u < 1024) { GlaIn gnx = gin; if (u + G < 1024) gla_chunk_load(u + G, gnx, QS, KB, VB, LA);
                    gla_chunk_unit(u, gin, lds, QT, OI, DS, DEC); gin = gnx; }
                else conv_unit(u - 1024, lds, UB, I.conv_w + l * CW * CCH, I.conv_b + l * CCH, I.cn_w + l * CCH, I.cn_b + l * CCH, MIX);
            }
        }
        SEAM(pb + 1);
        if (IN(pb + 2)) { PH_IDS;
            for (int idx = bx * NTHR + tid; idx < NB * H * DV * DK; idx += G * NTHR) {
                const int bh = idx >> 13, vd = idx & 8191, d = idx & 63; float S = 0.f;
                const float* dsp = DS + (size_t)bh * 64 * 8192 + vd; const float* dcp = DEC + (size_t)bh * 64 * 64 + d; bf16* spp = SP + (size_t)bh * 64 * 8192 + vd;
                for (int nb = 0; nb < NCH; nb += 16) {
                    float dv[16], av[16];
#pragma unroll
                    for (int i = 0; i < 16; ++i) { dv[i] = dsp[(size_t)(nb + i) * 8192]; av[i] = dcp[(nb + i) * 64]; }
#pragma unroll
                    for (int i = 0; i < 16; ++i) { spp[(size_t)(nb + i) * 8192] = (bf16)f2bf(S); S = av[i] * S + dv[i]; }
                }
            }
        }
        SEAM(pb + 2);
        if (IN(pb + 3)) {
            for (int u = bx; u < 1024; u += G) gla_out_unit(u, lds, QT, SP, OI, SG, I.gla_norm_w + l * DV, MIX);
        }
        SEAM(pb + 3);
        if (IN(pb + 4)) {
            pg8::StaticOrder<D / 256> S; S.init(M / 256, G, bx, Wout);
            pg8::EpiRes E{XB, SSQ, l == 1 ? ws + WS_XB8 : nullptr};
            pg8::gemm_phase<pg8::EpiRes, pg8::StaticOrder<D / 256>, false, true>(lds, (LAS float*)(lds + MISC_OFF + 64), MIX, D, S, E);
        }
        SEAM(pb + 4);
        if (l == 0) {
            if (IN(6)) {
                pg8::StaticOrder<NGU / 256, false> S; S.init(M / 256, G, bx, (const bf16*)(ws + WS_WDGU));
                pg8::EpiUp E{SSQ, ACT};
                pg8::gemm_phase<pg8::EpiUp, pg8::StaticOrder<NGU / 256, false>, true, true>(lds, (LAS float*)(lds + MISC_OFF + 64), XB, D, S, E);
            }
            SEAM(6);
            if (IN(7)) {
                pg8::StaticOrder<D / 256> S; S.init(M / 256, G, bx, (const bf16*)(ws + WS_WDD));
                pg8::EpiRes E{XB, SSQ, nullptr};
                pg8::gemm_phase<pg8::EpiRes, pg8::StaticOrder<D / 256>, false, true>(lds, (LAS float*)(lds + MISC_OFF + 64), ACT, FF, S, E);
            }
            SEAM(7);
        }
    }
    if (IN(13)) { PH_IDS;
        LAS int* sel = (LAS int*)lds;
        f32x4 wq[4][4][2];
#pragma unroll
        for (int j = 0; j < 4; ++j)
#pragma unroll
            for (int c = 0; c < 4; ++c) { const int k = 256 * j + 4 * lane + c; const float lw = I.ln2_w[D + k]; const f32x4* wp = (const f32x4*)(I.w_router + (size_t)k * NE); wq[j][c][0] = wp[0] * lw; wq[j][c][1] = wp[1] * lw; }
        for (int rb = bx; rb < M / 64; rb += G) {
            unsigned long long xw[8][4];
#pragma unroll
            for (int k8 = 0; k8 < 8; ++k8) { const unsigned long long* xr = (const unsigned long long*)(XB + (size_t)(rb * 64 + wave * 8 + k8) * D) + lane;
#pragma unroll
                for (int j = 0; j < 4; ++j) xw[k8][j] = xr[64 * j]; }
            float val[9][8];
#pragma unroll
            for (int k8 = 0; k8 < 8; ++k8) {
                f32x4 l0 = (f32x4){0.f, 0.f, 0.f, 0.f}, l1 = l0; float ss = 0.f;
#pragma unroll
                for (int j = 0; j < 4; ++j) { const unsigned long long w8 = xw[k8][j];
                    const float xe[4] = {__uint_as_float((unsigned)(w8 << 16)), __uint_as_float((unsigned)w8 & 0xffff0000u), __uint_as_float((unsigned)(w8 >> 32) << 16), __uint_as_float((unsigned)(w8 >> 32) & 0xffff0000u)};
#pragma unroll
                    for (int c = 0; c < 4; ++c) { const float x = xe[c]; ss += x * x; l0 += wq[j][c][0] * x; l1 += wq[j][c][1] * x; } }
#pragma unroll
                for (int e = 0; e < 4; ++e) { val[e][k8] = l0[e]; val[4 + e][k8] = l1[e]; }
                val[8][k8] = ss;
            }
            const bool b5 = (lane & 32) != 0, b4 = (lane & 16) != 0, b3 = (lane & 8) != 0;
            float v1[9];
#pragma unroll
            for (int q = 0; q < 9; ++q) { float v4[4], v2[2];
#pragma unroll
                for (int t = 0; t < 4; ++t) { const float keep = b5 ? val[q][t + 4] : val[q][t], send = b5 ? val[q][t] : val[q][t + 4]; v4[t] = keep + __shfl_xor(send, 32); }
#pragma unroll
                for (int t = 0; t < 2; ++t) { const float keep = b4 ? v4[t + 2] : v4[t], send = b4 ? v4[t] : v4[t + 2]; v2[t] = keep + __shfl_xor(send, 16); }
                const float keep = b3 ? v2[1] : v2[0], send = b3 ? v2[0] : v2[1]; float x = keep + __shfl_xor(send, 8);
                x += __shfl_xor(x, 4); x += __shfl_xor(x, 2); x += __shfl_xor(x, 1); v1[q] = x; }
            { const int tk = lane >> 3, m = rb * 64 + wave * 8 + tk; const float r = rsqrtf(v1[8] * (1.f / D) + EPS);
                float lg[NE];
#pragma unroll
                for (int e = 0; e < NE; ++e) lg[e] = v1[e] * r;
                int e1 = 0; float vv1 = lg[0];
#pragma unroll
                for (int e = 1; e < NE; ++e) if (lg[e] > vv1) { vv1 = lg[e]; e1 = e; }
                int e2 = -1; float vv2 = -3.0e38f;
#pragma unroll
                for (int e = 0; e < NE; ++e) if (e != e1 && lg[e] > vv2) { vv2 = lg[e]; e2 = e; }
                const float p2 = __expf(vv2 - vv1), g1 = 1.f / (1.f + p2), g2 = p2 / (1.f + p2);
                if ((lane & 7) == 0) { SEL[m * 4 + 0] = e1; SEL[m * 4 + 1] = e2; SEL[m * 4 + 2] = __float_as_int(g1); SEL[m * 4 + 3] = __float_as_int(g2); sel[(wave * 8 + tk) * 2] = e1; sel[(wave * 8 + tk) * 2 + 1] = e2; }
            }
            __syncthreads();
            if (wave == 0) { const int e1 = sel[lane * 2], e2 = sel[lane * 2 + 1];
#pragma unroll
                for (int e = 0; e < NE; ++e) { const int cnt = __popcll(__ballot(e1 == e)) + __popcll(__ballot(e2 == e)); if (lane == 0) CNT[rb * NE + e] = cnt; } }
            __syncthreads();
        }
    }
    SEAM(13);
    if (IN(14)) { PH_IDS;
        LAS int* tab = (LAS int*)lds;
        for (int rb = bx; rb < M / 64; rb += G) {
            if (wave == 0) {
#pragma unroll
                for (int e = 0; e < NE; ++e) { int tot = 0, pre = 0;
#pragma unroll
                    for (int q = 0; q < 4; ++q) { const int r2 = lane + 64 * q; const int c = CNT[r2 * NE + e]; tot += c; pre += (r2 < rb) ? c : 0; }
#pragma unroll
                    for (int o = 1; o < 64; o <<= 1) { tot += __shfl_xor(tot, o); pre += __shfl_xor(pre, o); }
                    if (lane == 0) { tab[e] = tot; tab[16 + e] = pre; } }
                asm volatile("s_waitcnt lgkmcnt(0)" ::: "memory");
                if (lane == 0) { int off = 0;
                    for (int e = 0; e < NE; ++e) { tab[8 + e] = off; tab[16 + e] += off; off += ((tab[e] + 255) >> 8) << 8; }
                    tab[24] = off >> 8; }
                asm volatile("s_waitcnt lgkmcnt(0)" ::: "memory");
                const int m = rb * 64 + lane; const int e1 = SEL[m * 4], e2 = SEL[m * 4 + 1]; const float g1 = __int_as_float(SEL[m * 4 + 2]), g2 = __int_as_float(SEL[m * 4 + 3]);
                const unsigned long long lt = (1ull << lane) - 1ull;
#pragma unroll
                for (int e = 0; e < NE; ++e) { const unsigned long long m1 = __ballot(e1 == e), m2 = __ballot(e2 == e); const int base = tab[16 + e];
                    if (e1 == e) { const int pos = base + __popcll(m1 & lt); ROWINFO[pos] = m | 0x8000; ROWG[pos] = g1; }
                    if (e2 == e) { const int pos = base + __popcll(m1) + __popcll(m2 & lt); ROWINFO[pos] = m | 0x4000 | 0x8000; ROWG[pos] = g2; } }
                if (rb < NE) { const int tot = tab[rb], off = tab[8 + rb], pad = ((tot + 255) >> 8) << 8;
                    for (int p = tot + lane; p < pad; p += 64) { ROWINFO[off + p] = 0; ROWG[off + p] = 0.f; }
                    for (int tI = lane; tI < (pad >> 8); tI += 64) TILEE[(off >> 8) + tI] = rb; }
                if (rb == 0 && lane == 0) TILEE[255] = tab[24];
            }
            __syncthreads();
        }
    }
    SEAM(14);
    if (IN(15)) {
        const int NT = __builtin_amdgcn_readfirstlane(__hip_atomic_load(TILEE + 255, __ATOMIC_RELAXED, __HIP_MEMORY_SCOPE_AGENT));
        LAS int* tile_l = (LAS int*)(lds + MISC_OFF + 8192);
        if (threadIdx.x < MAXTILES) tile_l[threadIdx.x] = TILEE[threadIdx.x];
        __syncthreads();
        pg8::MoeOrder<true, NGU / 256, false> S; S.init(NT, G, bx, ws + WS_WMGU, (size_t)NGU * D, tile_l, ROWINFO);
        pg8::EpiUpMoe E{SSQ, ROWINFO, ROWG, ws + WS_ACTM};
        pg8::gemm_phase<pg8::EpiUpMoe, pg8::MoeOrder<true, NGU / 256, false>, true, true, true, 0x79797979, 0x7f7f7f7f>(lds, (LAS float*)(lds + MISC_OFF + 64), ws + WS_XB8, D, S, E);
    }
    SEAM(15);
    if (IN(16)) {
        const int NT = __builtin_amdgcn_readfirstlane(__hip_atomic_load(TILEE + 255, __ATOMIC_RELAXED, __HIP_MEMORY_SCOPE_AGENT));
        LAS int* tile_l = (LAS int*)(lds + MISC_OFF + 8192);
        if (threadIdx.x < MAXTILES) tile_l[threadIdx.x] = TILEE[threadIdx.x];
        __syncthreads();
        pg8::MoeOrder<false, D / 256, false> S; S.init(NT, G, bx, ws + WS_WMD, (size_t)D * FF, tile_l, ROWINFO);
        pg8::EpiDownMoe E{ROWINFO, (bf16*)XA};
        pg8::gemm_phase<pg8::EpiDownMoe, pg8::MoeOrder<false, D / 256, false>, true, true, true, 0x79797979, 0x7b7b7b7b>(lds, (LAS float*)(lds + MISC_OFF + 64), ws + WS_ACTM, FF, S, E);
    }
    SEAM(16);
    if (IN(17)) { PH_IDS;
        const int gw = bx * NWAVES + wave, NGW = G * NWAVES;
        f32x4 wv[4];
#pragma unroll
        for (int j = 0; j < 4; ++j) wv[j] = ((const f32x4*)I.final_w)[lane + 64 * j];
        unsigned long long a0[4], a1[4], a2[4];
        int m = gw;
        if (m < M) { const unsigned long long* y0 = (const unsigned long long*)((const bf16*)XA + (size_t)m * 2048) + lane; const unsigned long long* xb = (const unsigned long long*)(XB + (size_t)m * D) + lane;
#pragma unroll
            for (int j = 0; j < 4; ++j) { a0[j] = y0[64 * j]; a1[j] = y0[256 + 64 * j]; a2[j] = xb[64 * j]; } }
        while (m < M) { const int mn = m + NGW; unsigned long long b0[4], b1[4], b2[4];
            if (mn < M) { const unsigned long long* y0 = (const unsigned long long*)((const bf16*)XA + (size_t)mn * 2048) + lane; const unsigned long long* xb = (const unsigned long long*)(XB + (size_t)mn * D) + lane;
#pragma unroll
                for (int j = 0; j < 4; ++j) { b0[j] = y0[64 * j]; b1[j] = y0[256 + 64 * j]; b2[j] = xb[64 * j]; } }
            f32x4 v[4]; float s = 0.f;
#pragma unroll
            for (int j = 0; j < 4; ++j) {
                v[j][0] = __uint_as_float((unsigned)(a0[j] << 16)) + __uint_as_float((unsigned)(a1[j] << 16)) + __uint_as_float((unsigned)(a2[j] << 16));
                v[j][1] = __uint_as_float((unsigned)a0[j] & 0xffff0000u) + __uint_as_float((unsigned)a1[j] & 0xffff0000u) + __uint_as_float((unsigned)a2[j] & 0xffff0000u);
                v[j][2] = __uint_as_float((unsigned)(a0[j] >> 32) << 16) + __uint_as_float((unsigned)(a1[j] >> 32) << 16) + __uint_as_float((unsigned)(a2[j] >> 32) << 16);
                v[j][3] = __uint_as_float((unsigned)(a0[j] >> 32) & 0xffff0000u) + __uint_as_float((unsigned)(a1[j] >> 32) & 0xffff0000u) + __uint_as_float((unsigned)(a2[j] >> 32) & 0xffff0000u);
                s += (v[j].x * v[j].x + v[j].y * v[j].y) + (v[j].z * v[j].z + v[j].w * v[j].w); }
            const float r = rsqrtf(wave_sum(s) * (1.f / D) + EPS);
            f32x4* xr = (f32x4*)(XA + (size_t)m * D) + lane;
#pragma unroll
            for (int j = 0; j < 4; ++j) xr[64 * j] = v[j] * r * wv[j];
#pragma unroll
            for (int j = 0; j < 4; ++j) { a0[j] = b0[j]; a1[j] = b1[j]; a2[j] = b2[j]; }
            m = mn; }
    }
#undef IN
#undef SEAM
#undef PH_IDS
#undef XB
#undef QS
#undef KB
#undef VB
#undef SG
#undef UB
#undef MIX
#undef ACT
#undef QT
#undef OI
#undef SP
#undef ACTM
#undef Y1
#undef SSQ
#undef LA
#undef DS
#undef DEC
#undef ROWG
#undef SEL
#undef CNT
#undef ROWINFO
#undef TILEE
}
extern "C" void kernel_launch(void* const* d_in, const int* in_sizes, int n_in, void* d_out, int out_size, void* d_ws, size_t ws_size, hipStream_t stream) {
    static int grid = 0;
    if (grid == 0) {
        if (n_in != 20 || in_sizes[0] != M * D || out_size != M * D || ws_size < WS_END) { fprintf(stderr, "kernel_launch: unexpected shapes/workspace (n_in %d, ws %zu, need %zu)\n", n_in, ws_size, (size_t)WS_END); grid = -1; return; }
        int dev = 0, cus = 0, per_cu = 0;
        if (hipGetDevice(&dev) != hipSuccess || hipDeviceGetAttribute(&cus, hipDeviceAttributeMultiprocessorCount, dev) != hipSuccess) { grid = -1; return; }
        if (hipFuncSetAttribute((const void*)mk_fwd, hipFuncAttributeMaxDynamicSharedMemorySize, LDS_BYTES) != hipSuccess) { fprintf(stderr, "kernel_launch: hipFuncSetAttribute failed\n"); grid = -1; return; }
        if (hipOccupancyMaxActiveBlocksPerMultiprocessor(&per_cu, (const void*)mk_fwd, NTHR, LDS_BYTES) != hipSuccess || per_cu < 1) { fprintf(stderr, "kernel_launch: occupancy query says %d\n", per_cu); per_cu = 1; }
        (void)hipGetLastError();
        grid = cus;
    }
    if (grid < 0) return;
    unsigned char* ws = (unsigned char*)d_ws;
    (void)hipMemsetAsync(ws + WS_CTL, 0, 32768, stream);
    Args a{};
    { const float** p = (const float**)&a.I; for (int i = 0; i < 20; ++i) p[i] = (const float*)d_in[i]; }
    a.out = (float*)d_out; a.ws = ws; a.ph_lo = 0; a.ph_hi = 18;
    hipLaunchKernelGGL(mk_fwd, dim3(grid), dim3(NTHR), LDS_BYTES, stream, a);
}
```

```cpp
#include <hip/hip_runtime.h>
#include <cstdio>
#include <cstdint>

typedef unsigned short bf16;
typedef unsigned v4u __attribute__((ext_vector_type(4)));
typedef float f32x4 __attribute__((ext_vector_type(4)));
#define LAS __attribute__((address_space(3)))

constexpr int D = 1024, NB = 4, T = 4096, M = NB * T;
constexpr int H = 4, DK = 64, DV = 128, KEY = 256, VAL = 512, RANK = 16, CCH = 512, CW = 31;
constexpr int INC = 2576, NIN = 2816;
constexpr int FF = 2816, NE = 8, NGU = 2 * FF;
constexpr float EPS = 1e-6f;
constexpr int CHUNK = 64, NCH = T / CHUNK;

constexpr size_t MiB = 1u << 20;
constexpr size_t WS_CTL = 0;
constexpr size_t WS_WMGU = 2 * MiB;
constexpr size_t WS_WMD = 46 * MiB;
constexpr size_t WS_XB8 = 68 * MiB;
constexpr size_t WS_WIN1 = 134 * MiB;
constexpr size_t WS_WOUT1 = 140 * MiB;
constexpr size_t WS_XB = 142 * MiB;
constexpr size_t WS_SSQ = 174 * MiB;
constexpr size_t WS_MISC = 175 * MiB;
constexpr size_t WS_WIN0 = 177 * MiB;
constexpr size_t WS_WOUT0 = 183 * MiB;
constexpr size_t WS_WDGU = 185 * MiB;
constexpr size_t WS_WDD = 196 * MiB;
constexpr size_t WS_TMP = 202 * MiB;
constexpr size_t WS_QS = WS_TMP, WS_KB = WS_TMP + 8 * MiB, WS_VB = WS_TMP + 16 * MiB, WS_SG = WS_TMP + 32 * MiB, WS_LA = WS_TMP + 48 * MiB, WS_UB = WS_TMP + 64 * MiB;
constexpr size_t WS_QT = WS_TMP + 80 * MiB, WS_OI = WS_TMP + 88 * MiB, WS_DS = WS_TMP + 104 * MiB, WS_SP = WS_TMP + 136 * MiB, WS_MIX = WS_TMP + 152 * MiB;
constexpr size_t WS_ACT = WS_TMP;
constexpr size_t WS_END = WS_TMP + 184 * MiB;
constexpr size_t MI_SEL = 0, MI_DEC = 768 * 1024;

__device__ __forceinline__ float bf2f(bf16 b) { return __uint_as_float(((unsigned)b) << 16); }
__device__ __forceinline__ unsigned f2bf(float f) { unsigned u = __float_as_uint(f); return (u + 0x7fffu + ((u >> 16) & 1u)) >> 16; }
__device__ __forceinline__ unsigned pk2(float lo, float hi) { return f2bf(lo) | (f2bf(hi) << 16); }
__device__ __forceinline__ float sigmoidf_(float x) { return 1.f / (1.f + __expf(-x)); }
__device__ __forceinline__ float siluf_(float x) { return x / (1.f + __expf(-x)); }
__device__ __forceinline__ float logsigf_(float x) { return fminf(x, 0.f) - log1pf(__expf(-fabsf(x))); }
__device__ __forceinline__ float wave_sum(float v) {
#pragma unroll
    for (int o = 1; o < 64; o <<= 1) v += __shfl_xor(v, o);
    return v;
}
__device__ __forceinline__ float row_rstd(const float* ssq, int row) {
    const f32x4* p = (const f32x4*)(ssq + (size_t)row * 16);
    f32x4 a = p[0], b = p[1], c = p[2], d = p[3];
    float s = ((a.x + a.y) + (a.z + a.w)) + ((b.x + b.y) + (b.z + b.w)) + ((c.x + c.y) + (c.z + c.w)) + ((d.x + d.y) + (d.z + d.w));
    return rsqrtf(s * (1.f / D) + EPS);
}

struct Inputs {
    const float *x, *ln1_w, *w_in, *w_gate_up, *b_gate, *gla_norm_w, *conv_w, *conv_b, *cn_w, *cn_b, *w_out, *ln2_w, *wd_gate, *wd_up, *wd_down, *w_router, *we_gate, *we_up, *we_down, *final_w;
};

constexpr float W8_MUL = 64.f;
struct CvtP { const float* W; const float* scale; void* WT; int ld, col0, K, row0, kb, nb, fp8; };
__device__ __forceinline__ void cvt_load(const CvtP& P, f32x4 (&v)[16], int lane) {
    const int k0 = 64 * P.kb, n0 = 64 * P.nb, n4 = 4 * (lane & 15), kq = lane >> 4;
#pragma unroll
    for (int i = 0; i < 16; ++i) v[i] = *(const f32x4*)(P.W + (size_t)(k0 + kq + 4 * i) * P.ld + P.col0 + n0 + n4);
}
__device__ __forceinline__ void cvt_finish(const CvtP& P, f32x4 (&v)[16], LAS float* scr, int lane) {
    const int k0 = 64 * P.kb, n0 = 64 * P.nb, n4 = 4 * (lane & 15), kq = lane >> 4; const float mul = P.fp8 ? W8_MUL : 1.f;
#pragma unroll
    for (int i = 0; i < 16; ++i) v[i] *= P.scale ? P.scale[k0 + kq + 4 * i] * mul : mul;
#pragma unroll
    for (int i = 0; i < 16; ++i) { const int k = kq + 4 * i; *(LAS f32x4*)(scr + k * 64 + (n4 ^ (4 * (k >> 3)))) = v[i]; }
    asm volatile("s_waitcnt lgkmcnt(0)" ::: "memory");
    if (P.fp8) { const int c = lane & 3; unsigned char* WT = (unsigned char*)P.WT;
#pragma unroll
        for (int j = 0; j < 4; ++j) { const int n = (lane >> 2) + 16 * j; unsigned w[4];
#pragma unroll
            for (int q = 0; q < 4; ++q) { float x[4];
#pragma unroll
                for (int r = 0; r < 4; ++r) { const int k = 16 * c + 4 * q + r; x[r] = scr[k * 64 + (n ^ (4 * (k >> 3)))]; }
                int t = 0; t = __builtin_amdgcn_cvt_pk_fp8_f32(x[0], x[1], t, false); t = __builtin_amdgcn_cvt_pk_fp8_f32(x[2], x[3], t, true); w[q] = (unsigned)t; }
            *(v4u*)(WT + (size_t)(P.row0 + n0 + n) * P.K + k0 + 16 * c) = (v4u){w[0], w[1], w[2], w[3]}; }
    } else { const int c = lane & 7; bf16* WT = (bf16*)P.WT;
#pragma unroll
        for (int j = 0; j < 8; ++j) { const int n = (lane >> 3) + 8 * j; const LAS float* sp = scr + (8 * c) * 64 + (n ^ (4 * c));
            v4u o; o.x = pk2(sp[0 * 64], sp[1 * 64]); o.y = pk2(sp[2 * 64], sp[3 * 64]); o.z = pk2(sp[4 * 64], sp[5 * 64]); o.w = pk2(sp[6 * 64], sp[7 * 64]);
            *(v4u*)(WT + (size_t)(P.row0 + n0 + n) * P.K + k0 + 8 * c) = o; }
    }
    asm volatile("s_waitcnt lgkmcnt(0)" ::: "memory");
}
constexpr int CVT_ITEMS = (20 + 20 + 8 + 8 + 44) * 32 + 8 * 88 + 8 * 44 * 32 + 8 * 8 * 88;
__device__ __forceinline__ CvtP cvt_decode(const Inputs& I, unsigned char* ws, int it) {
    CvtP P; int job, r = it; P.fp8 = 0; P.scale = nullptr; P.K = 1024;
    if (r < 40 * 32) { job = r / (20 * 32); r -= job * 20 * 32; const int seg = r / 32, q = r % 32;
        if (seg < 12) { P.col0 = 128 * seg; P.row0 = 128 * seg; } else { const int t = (seg - 12) >> 1, hf = (seg - 12) & 1; P.col0 = (hf ? 2064 : 1552) + 128 * t; P.row0 = 1792 + 256 * t + 128 * hf; }
        P.W = I.w_in + (size_t)job * D * INC; P.ld = INC; P.WT = ws + (job ? WS_WIN1 : WS_WIN0); P.scale = I.ln1_w + job * D; P.kb = q >> 1; P.nb = q & 1; return P; }
    r -= 40 * 32;
    if (r < 16 * 32) { job = r / (8 * 32); r -= job * 8 * 32; const int seg = r / 32, q = r % 32;
        P.W = I.w_out + (size_t)job * D * D; P.ld = D; P.col0 = 128 * seg; P.row0 = 128 * seg; P.WT = ws + (job ? WS_WOUT1 : WS_WOUT0); P.kb = q >> 1; P.nb = q & 1; return P; }
    r -= 16 * 32;
    if (r < 44 * 32) { const int seg = r / 32, q = r % 32, t = seg >> 1, hf = seg & 1;
        P.W = hf ? I.wd_up : I.wd_gate; P.ld = FF; P.col0 = 128 * t; P.row0 = 256 * t + 128 * hf; P.WT = ws + WS_WDGU; P.scale = I.ln2_w; P.kb = q >> 1; P.nb = q & 1; return P; }
    r -= 44 * 32;
    if (r < 8 * 88) { const int seg = r / 88, q = r % 88;
        P.W = I.wd_down; P.ld = D; P.col0 = 128 * seg; P.row0 = 128 * seg; P.K = FF; P.WT = ws + WS_WDD; P.kb = q >> 1; P.nb = q & 1; return P; }
    r -= 8 * 88;
    if (r < 8 * 44 * 32) { const int e = r / (44 * 32); r -= e * 44 * 32; const int seg = r / 32, q = r % 32, t = seg >> 1, hf = seg & 1;
        P.W = (hf ? I.we_up : I.we_gate) + (size_t)e * D * FF; P.ld = FF; P.col0 = 128 * t; P.row0 = 256 * t + 128 * hf; P.WT = ws + WS_WMGU + (size_t)e * NGU * D; P.scale = I.ln2_w + D; P.fp8 = 1; P.kb = q >> 1; P.nb = q & 1; return P; }
    r -= 8 * 44 * 32;
    { const int e = r / (8 * 88); r -= e * 8 * 88; const int seg = r / 88, q = r % 88;
        P.W = I.we_down + (size_t)e * FF * D; P.ld = D; P.col0 = 128 * seg; P.row0 = 128 * seg; P.K = FF; P.WT = ws + WS_WMD + (size_t)e * D * FF; P.fp8 = 1; P.kb = q >> 1; P.nb = q & 1; return P; }
}
__device__ __forceinline__ void cvt_all(const Inputs& I, unsigned char* ws, int gw, int NGW, LAS float* scr, int lane) {
    int it = gw; if (it >= CVT_ITEMS) return;
    CvtP P = cvt_decode(I, ws, it); f32x4 v[16]; cvt_load(P, v, lane);
    for (;;) { const int itn = it + NGW; const bool more = itn < CVT_ITEMS;
        CvtP Pn = P; f32x4 vn[16];
        if (more) { Pn = cvt_decode(I, ws, itn); cvt_load(Pn, vn, lane); }
        cvt_finish(P, v, scr, lane);
        if (!more) break;
        P = Pn; it = itn;
#pragma unroll
        for (int i = 0; i < 16; ++i) v[i] = vn[i];
    }
}
__device__ __forceinline__ void cvt_gate_elem(const Inputs& I, unsigned char* ws, int idx) {
    const int l = idx >> 18, j = (idx >> 10) & 255, k = idx & 1023;
    const float* wr = I.w_in + (size_t)l * D * INC + (size_t)k * INC + 1536; const float* gu = I.w_gate_up + l * RANK * KEY + j;
    float s = 0.f;
#pragma unroll
    for (int r = 0; r < RANK; ++r) s += wr[r] * gu[r * KEY];
    bf16* dst = (bf16*)(ws + (l ? WS_WIN1 : WS_WIN0));
    dst[(size_t)(1536 + j) * D + k] = (bf16)f2bf(s * I.ln1_w[l * D + k]);
}
__device__ __forceinline__ void row_to_xb(const float* xrow, bf16* orow, float* ssqrow, int lane) {
    const f32x4* xr = (const f32x4*)xrow + lane; f32x4 v[4]; float s = 0.f;
#pragma unroll
    for (int j = 0; j < 4; ++j) { v[j] = xr[64 * j]; s += (v[j].x * v[j].x + v[j].y * v[j].y) + (v[j].z * v[j].z + v[j].w * v[j].w); }
    s = wave_sum(s);
    unsigned long long* o8 = (unsigned long long*)orow + lane;
#pragma unroll
    for (int j = 0; j < 4; ++j) o8[64 * j] = (unsigned long long)pk2(v[j].x, v[j].y) | ((unsigned long long)pk2(v[j].z, v[j].w) << 32);
    if (lane < 16) ssqrow[lane] = lane == 0 ? s : 0.f;
}

__device__ __forceinline__ int opaque_tid() { int t = threadIdx.x; asm volatile("" : "+v"(t)); return t; }
namespace pg8 {
#define PG8_LAS __attribute__((address_space(3)))
typedef short bf16x8 __attribute__((ext_vector_type(8)));
typedef unsigned u32x4 __attribute__((ext_vector_type(4)));
constexpr int BM = 256, BK = 64, HALF = 128, HTB = HALF * BK * 2  , STAGE_BYTES = 8 * HTB, NXCD = 8, WGM = 8;

__host__ __device__ __forceinline__ int lds_byte(int r, int c) { return r * 128 + ((((c >> 3) ^ ((r >> 1) & 7)) << 4)) + (c & 7) * 2; }
__host__ __device__ __forceinline__ void stage_rc(int b, int& R, int& C) { R = b >> 7; C = (((b >> 4) & 7) ^ ((R >> 1) & 7)) * 8; }
__host__ __device__ __forceinline__ int perm32(int rho) { const int n = rho >> 4, i = rho & 15; return 8 * (i >> 2) + 4 * n + (i & 3); }

struct Unit { int pm, pn, e, hm; };

__device__ __forceinline__ void unit_of(int wgid, int nM, int NN, int q, int r, int& pm, int& pn) {
    { const int xcd = wgid & (NXCD - 1), off = wgid >> 3; wgid = (xcd < r ? xcd * (q + 1) : r * (q + 1) + (xcd - r) * q) + off; }
    const int nig = WGM * NN, gid = wgid / nig, fm = gid * WGM, gsz = (nM - fm) < WGM ? (nM - fm) : WGM, rem = wgid - gid * nig;
    if (gsz == WGM) { pm = fm + (rem & (WGM - 1)); pn = rem >> 3; } else { pm = fm + rem % gsz; pn = rem / gsz; }
}
template <int NN, bool SPLIT = false> struct StaticOrder {
    static constexpr bool GATHER = false;
    int nM, nwg, G, c, q, r, nfull; const bf16* Bt;
    __device__ void init(int nM_, int G_, int c_, const bf16* Bt_) { nM = nM_; nwg = nM * NN; G = G_; c = c_; Bt = Bt_; q = nwg >> 3; r = nwg & 7; nfull = (SPLIT && 2 * (nwg % G) <= G) ? (nwg / G) * G : nwg; }
    __device__ __forceinline__ bool next(int i, Unit& u) const { int L = i * G + c; u.hm = -1; u.e = 0;
        if (L >= nfull) { const int j = L - nfull; if (j >= 2 * (nwg - nfull)) return false; L = nfull + (j >> 1); u.hm = j & 1; }
        unit_of(L, nM, NN, q, r, u.pm, u.pn); return true; }
    __device__ __forceinline__ const void* bt_root() const { return Bt; }
    __device__ __forceinline__ int bt_off(const Unit&) const { return 0; }
    __device__ __forceinline__ int row_src(const Unit&, int) const { return 0; }
};
template <bool GATHER_, int NN, bool SPLIT = false> struct MoeOrder {
    static constexpr bool GATHER = GATHER_;
    int nM, nwg, G, c, q, r, nfull; const char* Bt; size_t estride; const PG8_LAS int* tile_e; const int* rowinfo;
    __device__ void init(int nM_, int G_, int c_, const void* Bt_, size_t estride_, const PG8_LAS int* tile_e_, const int* rowinfo_) { nM = nM_; nwg = nM * NN; G = G_; c = c_; Bt = (const char*)Bt_; estride = estride_; tile_e = tile_e_; rowinfo = rowinfo_; q = nwg >> 3; r = nwg & 7;
        nfull = (SPLIT && 2 * (nwg % G) <= G) ? (nwg / G) * G : nwg; }
    __device__ __forceinline__ bool next(int i, Unit& u) const { int L = i * G + c; u.hm = -1;
        if (L >= nfull) { const int j = L - nfull; if (j >= 2 * (nwg - nfull)) return false; L = nfull + (j >> 1); u.hm = j & 1; }
        unit_of(L, nM, NN, q, r, u.pm, u.pn); u.e = __builtin_amdgcn_readfirstlane(tile_e[u.pm]); return true; }
    __device__ __forceinline__ const void* bt_root() const { return Bt; }
    __device__ __forceinline__ int bt_off(const Unit& u) const { return u.e * (int)estride; }
    __device__ __forceinline__ int row_src(const Unit& u, int R) const { return __hip_atomic_load(rowinfo + u.pm * BM + (u.hm > 0 ? HALF : 0) + R, __ATOMIC_RELAXED, __HIP_MEMORY_SCOPE_AGENT) & 0x3fff; }
};

typedef int v4i_ __attribute__((ext_vector_type(4)));
typedef int v8i_ __attribute__((ext_vector_type(8)));
__device__ __forceinline__ v8i_ cat8(const bf16x8 a, const bf16x8 b) { const v4i_ x = __builtin_bit_cast(v4i_, a), y = __builtin_bit_cast(v4i_, b); return __builtin_shufflevector(x, y, 0, 1, 2, 3, 4, 5, 6, 7); }
__device__ __forceinline__ unsigned cvt_pk_bf16(float lo, float hi) { unsigned r; asm volatile("v_cvt_pk_bf16_f32 %0, %1, %2" : "=v"(r) : "v"(lo), "v"(hi)); return r; }
__device__ __forceinline__ u32x4 pack8(const f32x4 a, const f32x4 b) { u32x4 w; w.x = cvt_pk_bf16(a[0], a[1]); w.y = cvt_pk_bf16(a[2], a[3]); w.z = cvt_pk_bf16(b[0], b[1]); w.w = cvt_pk_bf16(b[2], b[3]); return w; }

template <class Epi, class Sched, bool ALIGN_EPI = false, bool SP2 = false, bool FP8 = false, int SCALE_W = 0x7f7f7f7f, int SCALE_X = 0x7f7f7f7f>
__device__ __forceinline__ void gemm_phase(PG8_LAS unsigned char* lds, PG8_LAS float* tab, const void* Abase, const int K, const Sched& S, const Epi& E) {
    const int tid = opaque_tid(), wid = __builtin_amdgcn_readfirstlane(tid >> 6), lane = tid & 63, wr = wid >> 2, wc = wid & 3, fr = lane & 15, fq = lane >> 4;
    const int rowb = FP8 ? K : 2 * K;
    const int nt = rowb / 128;
    Unit cur, nxt; int ui = 0;
    if (!S.next(0, cur)) return;
    bool has_next = S.next(1, nxt);
    E.prep_store(E.prep_load(cur, tid), tab, 0, tid); __builtin_amdgcn_sched_barrier(0);
    const int kstep = BK * 2;
    const int hstep = HALF * rowb;
    const int tstep = 2 * hstep;
    unsigned voffB[2], vA[2][2], vN[2][2];
#pragma unroll
    for (int i = 0; i < 2; ++i) { int R, C; stage_rc(tid * 16 + i * 8192, R, C); const int Rb = Epi::PERM ? ((R & ~31) + perm32(R & 31)) : R;
        voffB[i] = (unsigned)(Rb * rowb + C * 2);
#pragma unroll
        for (int h = 0; h < 2; ++h) { vA[h][i] = (unsigned)(R * rowb + C * 2); vN[h][i] = vA[h][i]; } }
    const int hA = Sched::GATHER ? 0 : hstep;
    const unsigned ldsw = (unsigned)wid * 1024u;
    const int aoff0 = lds_byte(wr * 64 + fr, fq * 8), aoff1 = lds_byte(wr * 64 + fr, 32 + fq * 8), boff0 = lds_byte(wc * 32 + fr, fq * 8), boff1 = lds_byte(wc * 32 + fr, 32 + fq * 8);
#define PG8_SA(b, h) (((b) * 2 + (h)) * HTB)
#define PG8_SB(b, h) ((4 + (b) * 2 + (h)) * HTB)
#define PG8_STAGE(bufoff, rsrc, soff, voff) do { _Pragma("unroll") for (int _i = 0; _i < 2; ++_i) \
        __builtin_amdgcn_raw_ptr_buffer_load_lds(rsrc, (PG8_LAS void*)(lds + (bufoff) + ldsw + _i * 8192), 16, (int)(voff)[_i], (int)(soff), 0, 0); } while (0)
#define PG8_LD8(p0, p1) __builtin_shufflevector(*(const PG8_LAS v4i_*)(p0), *(const PG8_LAS v4i_*)(p1), 0, 1, 2, 3, 4, 5, 6, 7)
#define PG8_LDA(dst, b, h) do { if constexpr (FP8) { _Pragma("unroll") for (int m = 0; m < 4; ++m) dst##8[m] = PG8_LD8(lds + PG8_SA(b, h) + aoff0 + m * 2048, lds + PG8_SA(b, h) + aoff1 + m * 2048); } else { \
        _Pragma("unroll") for (int m = 0; m < 4; ++m) { dst[m][0] = *(const PG8_LAS bf16x8*)(lds + PG8_SA(b, h) + aoff0 + m * 2048); dst[m][1] = *(const PG8_LAS bf16x8*)(lds + PG8_SA(b, h) + aoff1 + m * 2048); } } } while (0)
#define PG8_LDB(dst, b, h) do { if constexpr (FP8) { _Pragma("unroll") for (int n = 0; n < 2; ++n) dst##8[n] = PG8_LD8(lds + PG8_SB(b, h) + boff0 + n * 2048, lds + PG8_SB(b, h) + boff1 + n * 2048); } else { \
        _Pragma("unroll") for (int n = 0; n < 2; ++n) { dst[n][0] = *(const PG8_LAS bf16x8*)(lds + PG8_SB(b, h) + boff0 + n * 2048); dst[n][1] = *(const PG8_LAS bf16x8*)(lds + PG8_SB(b, h) + boff1 + n * 2048); } } } while (0)
#define PG8_MMA(ai, bj, At, Bt) do { __builtin_amdgcn_s_setprio(1); if constexpr (FP8) { _Pragma("unroll") for (int m = 0; m < 4; ++m) _Pragma("unroll") for (int n = 0; n < 2; ++n) \
        asm volatile("v_mfma_scale_f32_16x16x128_f8f6f4 %0, %1, %2, %0, %3, %4 op_sel_hi:[0,0,0]" : "+v"(acc[ai][bj][m][n]) : "v"(Bt##8[n]), "v"(At##8[m]), "v"(scw), "v"(scx)); } else { \
        _Pragma("unroll") for (int m = 0; m < 4; ++m) _Pragma("unroll") for (int n = 0; n < 2; ++n) _Pragma("unroll") for (int k = 0; k < 2; ++k) \
        acc[ai][bj][m][n] = __builtin_amdgcn_mfma_f32_16x16x32_bf16(Bt[n][k], At[m][k], acc[ai][bj][m][n], 0, 0, 0); } __builtin_amdgcn_s_setprio(0); } while (0)
#define PG8_WAIT_V(n) asm volatile("s_waitcnt vmcnt(" #n ")" ::: "memory")
#define PG8_WAIT_L(n) asm volatile("s_waitcnt lgkmcnt(" #n ")" ::: "memory")
#define PG8_BAR __builtin_amdgcn_s_barrier()
#define PG8_SCHED __builtin_amdgcn_sched_barrier(0)
    f32x4 acc[2][2][4][2];
#pragma unroll
    for (int a = 0; a < 2; ++a)
#pragma unroll
        for (int b = 0; b < 2; ++b)
#pragma unroll
            for (int m = 0; m < 4; ++m)
#pragma unroll
                for (int n = 0; n < 2; ++n) acc[a][b][m][n] = (f32x4){0.f, 0.f, 0.f, 0.f};
    int scw = SCALE_W, scx = SCALE_X; asm volatile("" : "+v"(scw), "+v"(scx));
    bf16x8 At[4][2], B0[2][2], B1[2][2]; v8i_ At8[4], B08[2], B18[2];
    const __amdgpu_buffer_rsrc_t rA = __builtin_amdgcn_make_buffer_rsrc((void*)Abase, 0, 0xffffffff, 0x00020000), rB = __builtin_amdgcn_make_buffer_rsrc((void*)S.bt_root(), 0, 0xffffffff, 0x00020000);
    int cA, cB = S.bt_off(cur) + cur.pn * tstep;
    if constexpr (Sched::GATHER) {
        cA = 0;
#pragma unroll
        for (int h = 0; h < 2; ++h)
#pragma unroll
            for (int i = 0; i < 2; ++i) { int R, C; stage_rc(tid * 16 + i * 8192, R, C); vA[h][i] = (unsigned)(S.row_src(cur, h * HALF + R) * rowb + C * 2); vN[h][i] = has_next ? (unsigned)(S.row_src(nxt, h * HALF + R) * rowb + C * 2) : vA[h][i]; }
    } else cA = cur.pm * tstep + (cur.hm > 0 ? hstep : 0);
    asm volatile("" : "+v"(voffB[0]), "+v"(voffB[1]), "+v"(vA[0][0]), "+v"(vA[0][1]), "+v"(vA[1][0]), "+v"(vA[1][1]));
    if constexpr (SP2) {
        PG8_STAGE(PG8_SB(0, 0), rB, cB, voffB); PG8_STAGE(PG8_SB(0, 1), rB, cB + hstep, voffB); PG8_STAGE(PG8_SA(0, 0), rA, cA, vA[0]); PG8_STAGE(PG8_SA(0, 1), rA, cA + hA, vA[1]);
        if (wr == 1) PG8_BAR;
        PG8_WAIT_V(2); PG8_BAR;
        PG8_STAGE(PG8_SB(1, 0), rB, cB + kstep, voffB); PG8_STAGE(PG8_SA(1, 0), rA, cA + kstep, vA[0]); PG8_STAGE(PG8_SB(1, 1), rB, cB + hstep + kstep, voffB);
        PG8_WAIT_V(6); PG8_BAR;
    } else {
        PG8_STAGE(PG8_SB(0, 0), rB, cB, voffB); PG8_STAGE(PG8_SA(0, 0), rA, cA, vA[0]); PG8_STAGE(PG8_SB(0, 1), rB, cB + hstep, voffB); PG8_STAGE(PG8_SA(0, 1), rA, cA + hA, vA[1]);
        if (wr == 1) PG8_BAR;
        PG8_WAIT_V(4); PG8_BAR;
        PG8_STAGE(PG8_SB(1, 0), rB, cB + kstep, voffB); PG8_STAGE(PG8_SA(1, 0), rA, cA + kstep, vA[0]); PG8_STAGE(PG8_SB(1, 1), rB, cB + hstep + kstep, voffB);
        PG8_WAIT_V(6); PG8_BAR;
    }
    for (;;) {
        int nA; const int nB = has_next ? S.bt_off(nxt) + nxt.pn * tstep : cB;
        if constexpr (Sched::GATHER) nA = cA; else nA = has_next ? nxt.pm * tstep + (nxt.hm > 0 ? hstep : 0) : cA;
        const bool whole = cur.hm < 0;
#pragma clang loop unroll(disable)
        for (int t = 0; t < nt; t += 2) {
            const bool last = (t == nt - 2);
            const int a1 = cA + (t + 1) * kstep;
            const int a2 = last ? nA : cA + (t + 2) * kstep; const int b2 = last ? nB : cB + (t + 2) * kstep;
            const int a3 = a2 + kstep; const int b3 = b2 + kstep;
            unsigned v2[2][2];
#pragma unroll
            for (int h = 0; h < 2; ++h)
#pragma unroll
                for (int i = 0; i < 2; ++i) v2[h][i] = (Sched::GATHER && last) ? vN[h][i] : vA[h][i];
            if constexpr (SP2) {
            PG8_LDB(B0, 0, 0); PG8_LDB(B1, 0, 1); PG8_SCHED; PG8_LDA(At, 0, 0); PG8_STAGE(PG8_SA(1, 1), rA, a1 + hA, vA[1]);
            PG8_WAIT_V(8); PG8_WAIT_L(0); PG8_BAR; PG8_MMA(0, 0, At, B0); PG8_MMA(0, 1, At, B1); PG8_BAR; PG8_SCHED;
            PG8_LDA(At, 0, 1); PG8_STAGE(PG8_SB(0, 0), rB, b2, voffB); PG8_STAGE(PG8_SB(0, 1), rB, b2 + hstep, voffB); PG8_STAGE(PG8_SA(0, 0), rA, a2, v2[0]);
            PG8_WAIT_V(8); PG8_WAIT_L(0); PG8_BAR; if (whole) { PG8_MMA(1, 0, At, B0); PG8_MMA(1, 1, At, B1); } PG8_BAR; PG8_SCHED;
            PG8_LDB(B0, 1, 0); PG8_LDB(B1, 1, 1); PG8_SCHED; PG8_LDA(At, 1, 0); PG8_STAGE(PG8_SA(0, 1), rA, a2 + hA, v2[1]);
            PG8_WAIT_V(8); PG8_WAIT_L(0); PG8_BAR; PG8_MMA(0, 0, At, B0); PG8_MMA(0, 1, At, B1); PG8_BAR; PG8_SCHED;
            PG8_LDA(At, 1, 1); PG8_STAGE(PG8_SB(1, 0), rB, b3, voffB); PG8_STAGE(PG8_SB(1, 1), rB, b3 + hstep, voffB); PG8_STAGE(PG8_SA(1, 0), rA, a3, v2[0]);
            PG8_WAIT_V(8); PG8_WAIT_L(0); PG8_BAR; if (whole) { PG8_MMA(1, 0, At, B0); PG8_MMA(1, 1, At, B1); } PG8_BAR; PG8_SCHED;
            } else {
            PG8_LDB(B0, 0, 0); PG8_SCHED; PG8_LDA(At, 0, 0); PG8_STAGE(PG8_SA(1, 1), rA, a1 + hA, vA[1]);
            PG8_WAIT_L(8); PG8_BAR; PG8_WAIT_L(0); PG8_MMA(0, 0, At, B0); PG8_BAR; PG8_SCHED;
            PG8_LDB(B1, 0, 1); PG8_STAGE(PG8_SB(0, 0), rB, b2, voffB);
            PG8_BAR; PG8_WAIT_L(0); PG8_MMA(0, 1, At, B1); PG8_BAR;
            PG8_LDA(At, 0, 1); PG8_STAGE(PG8_SA(0, 0), rA, a2, v2[0]);
            PG8_BAR; PG8_WAIT_L(0); PG8_MMA(1, 0, At, B0); PG8_BAR; PG8_SCHED;
            PG8_STAGE(PG8_SB(0, 1), rB, b2 + hstep, voffB);
            PG8_WAIT_V(6); PG8_BAR; PG8_MMA(1, 1, At, B1); PG8_BAR;
            PG8_LDB(B0, 1, 0); PG8_SCHED; PG8_LDA(At, 1, 0); PG8_STAGE(PG8_SA(0, 1), rA, a2 + hA, v2[1]);
            PG8_WAIT_L(8); PG8_BAR; PG8_WAIT_L(0); PG8_MMA(0, 0, At, B0); PG8_BAR; PG8_SCHED;
            PG8_LDB(B1, 1, 1); PG8_STAGE(PG8_SB(1, 0), rB, b3, voffB);
            PG8_BAR; PG8_WAIT_L(0); PG8_MMA(0, 1, At, B1); PG8_BAR;
            PG8_LDA(At, 1, 1); PG8_STAGE(PG8_SA(1, 0), rA, a3, v2[0]);
            PG8_BAR; PG8_WAIT_L(0); PG8_MMA(1, 0, At, B0); PG8_BAR; PG8_SCHED;
            PG8_STAGE(PG8_SB(1, 1), rB, b3 + hstep, voffB);
            PG8_WAIT_V(6); PG8_BAR; PG8_MMA(1, 1, At, B1); PG8_BAR;
            }
        }
        if constexpr (ALIGN_EPI) { if (wr == 0) PG8_BAR; }
        if constexpr (FP8) asm volatile("s_nop 15\n\ts_nop 15" ::: "memory");
        const int tid2 = opaque_tid(), lane2 = tid2 & 63;
        typename Epi::Prep pr; if (has_next) pr = E.prep_load(nxt, tid2);
        E(acc, cur, tab + (ui & 1) * 512, wr, wc, lane2 & 15, lane2 >> 4);
        if (!has_next) break;
        E.prep_store(pr, tab, (ui + 1) & 1, tid2); __builtin_amdgcn_sched_barrier(0);
#pragma unroll
        for (int a = 0; a < 2; ++a)
#pragma unroll
            for (int b = 0; b < 2; ++b)
#pragma unroll
                for (int m = 0; m < 4; ++m)
#pragma unroll
                    for (int n = 0; n < 2; ++n) acc[a][b][m][n] = (f32x4){0.f, 0.f, 0.f, 0.f};
        Unit nn; const bool has2 = S.next(ui + 2, nn);
        if constexpr (Sched::GATHER) {
#pragma unroll
            for (int h = 0; h < 2; ++h)
#pragma unroll
                for (int i = 0; i < 2; ++i) { int R, C; stage_rc(tid2 * 16 + i * 8192, R, C); const unsigned tnew = has2 ? (unsigned)(S.row_src(nn, h * HALF + R) * rowb + C * 2) : vN[h][i]; vA[h][i] = vN[h][i]; vN[h][i] = tnew; }
        }
        cur = nxt; nxt = nn; has_next = has2; cA = nA; cB = nB; ++ui;
        if constexpr (ALIGN_EPI) { if (wr == 1) PG8_BAR; }
    }
    PG8_WAIT_V(0);
    if constexpr (!ALIGN_EPI) { if (wr == 0) PG8_BAR; }
    PG8_BAR;
#undef PG8_SA
#undef PG8_SB
#undef PG8_STAGE
#undef PG8_LDA
#undef PG8_LDB
#undef PG8_MMA
#undef PG8_WAIT_V
#undef PG8_WAIT_L
#undef PG8_BAR
#undef PG8_SCHED
}
}
namespace pg8 {
__device__ __forceinline__ float silu_fast(float x) { return x * __builtin_amdgcn_rcpf(1.f + __expf(-x)); }
__device__ __forceinline__ float sigm_fast(float x) { return __builtin_amdgcn_rcpf(1.f + __expf(-x)); }
__device__ __forceinline__ f32x4 silu4(const f32x4 v) { f32x4 o; o[0] = silu_fast(v[0]); o[1] = silu_fast(v[1]); o[2] = silu_fast(v[2]); o[3] = silu_fast(v[3]); return o; }
__device__ __forceinline__ f32x4 sigm4(const f32x4 v) { f32x4 o; o[0] = sigm_fast(v[0]); o[1] = sigm_fast(v[1]); o[2] = sigm_fast(v[2]); o[3] = sigm_fast(v[3]); return o; }
__device__ __forceinline__ unsigned long long pack8_fp8(const f32x4 a, const f32x4 b) { int lo = 0, hi = 0; lo = __builtin_amdgcn_cvt_pk_fp8_f32(a[0], a[1], lo, false); lo = __builtin_amdgcn_cvt_pk_fp8_f32(a[2], a[3], lo, true);
    hi = __builtin_amdgcn_cvt_pk_fp8_f32(b[0], b[1], hi, false); hi = __builtin_amdgcn_cvt_pk_fp8_f32(b[2], b[3], hi, true); return (unsigned long long)(unsigned)lo | ((unsigned long long)(unsigned)hi << 32); }
__device__ __forceinline__ float logsig_fast(float x) { return fminf(x, 0.f) - __logf(1.f + __expf(-fabsf(x))); }
struct PrepNone { };
struct Prep2 { float a, b; };
struct EpiIn {
    static constexpr bool PERM = true; typedef Prep2 Prep;
    const float* ssq; const float* b_gate; bf16 *QS, *KB, *VB, *SG, *UB; float* LA;
    __device__ __forceinline__ Prep prep_load(const Unit& u, int tid) const { Prep p; p.b = 0.f; p.a = row_rstd(ssq, u.pm * BM + (u.hm > 0 ? HALF : 0) + (tid & 255)); return p; }
    __device__ __forceinline__ void prep_store(const Prep& p, PG8_LAS float* tab, int par, int tid) const { tab[par * 512 + (tid & 255)] = p.a; }
    __device__ __forceinline__ void operator()(const f32x4 (&acc)[2][2][4][2], const Unit& u, const PG8_LAS float* tb, int wr, int wc, int fr, int fq) const {
        const int tile = u.pn, cin = wc * 32 + 8 * fq, rb0 = u.pm * BM + (u.hm > 0 ? HALF : 0);
        f32x4 bg[2][2];
        if (tile == 6) {
#pragma unroll
            for (int bj = 0; bj < 2; ++bj)
#pragma unroll
                for (int n = 0; n < 2; ++n) bg[bj][n] = *(const f32x4*)(b_gate + bj * 128 + cin + 4 * n);
        }
#pragma unroll
        for (int ai = 0; ai < 2; ++ai) if (ai == 0 || u.hm < 0)
#pragma unroll
            for (int m = 0; m < 4; ++m) {
                const int lr = ai * HALF + wr * 64 + m * 16 + fr, row = rb0 + lr; const float r = tb[lr];
                const f32x4 l0 = acc[ai][0][m][0] * r, l1 = acc[ai][0][m][1] * r, h0 = acc[ai][1][m][0] * r, h1 = acc[ai][1][m][1] * r;
                if (tile == 0) { bf16* p = QS + (size_t)row * KEY + cin; *(u32x4*)p = pack8(l0 * 0.125f, l1 * 0.125f); *(u32x4*)(p + 128) = pack8(h0 * 0.125f, h1 * 0.125f); }
                else if (tile == 1) { bf16* p = KB + (size_t)row * KEY + cin; *(u32x4*)p = pack8(l0, l1); *(u32x4*)(p + 128) = pack8(h0, h1); }
                else if (tile < 4) { bf16* p = VB + (size_t)row * VAL + (tile - 2) * 256 + cin; *(u32x4*)p = pack8(l0, l1); *(u32x4*)(p + 128) = pack8(h0, h1); }
                else if (tile < 6) { bf16* p = SG + (size_t)row * VAL + (tile - 4) * 256 + cin; *(u32x4*)p = pack8(silu4(l0), silu4(l1)); *(u32x4*)(p + 128) = pack8(silu4(h0), silu4(h1)); }
                else if (tile == 6) { float* p = LA + (size_t)row * KEY + cin; f32x4 o;
#pragma unroll
                    for (int j = 0; j < 4; ++j) o[j] = logsig_fast(l0[j] + bg[0][0][j]) * 0.0625f; *(f32x4*)p = o;
#pragma unroll
                    for (int j = 0; j < 4; ++j) o[j] = logsig_fast(l1[j] + bg[0][1][j]) * 0.0625f; *(f32x4*)(p + 4) = o;
#pragma unroll
                    for (int j = 0; j < 4; ++j) o[j] = logsig_fast(h0[j] + bg[1][0][j]) * 0.0625f; *(f32x4*)(p + 128) = o;
#pragma unroll
                    for (int j = 0; j < 4; ++j) o[j] = logsig_fast(h1[j] + bg[1][1][j]) * 0.0625f; *(f32x4*)(p + 132) = o; }
                else { bf16* p = UB + (size_t)row * CCH + (tile - 7) * 128 + cin; *(u32x4*)p = pack8(l0 * sigm4(h0), l1 * sigm4(h1)); }
            }
    }
};
struct EpiRes {
    static constexpr bool PERM = true; typedef PrepNone Prep;
    bf16* XB; float* SSQ; unsigned char* X8;
    __device__ __forceinline__ Prep prep_load(const Unit&, int) const { return Prep(); }
    __device__ __forceinline__ void prep_store(const Prep&, PG8_LAS float*, int, int) const {}
    __device__ __forceinline__ void operator()(const f32x4 (&acc)[2][2][4][2], const Unit& u, const PG8_LAS float*, int wr, int wc, int fr, int fq) const {
        const int cin = wc * 32 + 8 * fq, rb0 = u.pm * BM + (u.hm > 0 ? HALF : 0); (void)rb0;
#pragma unroll
        for (int ai = 0; ai < 2; ++ai) if (ai == 0 || u.hm < 0) {
            u32x4 rv[4][2];
#pragma unroll
            for (int m = 0; m < 4; ++m) { const size_t o = (size_t)(rb0 + ai * HALF + wr * 64 + m * 16 + fr) * D + u.pn * BM + cin;
#pragma unroll
                for (int bj = 0; bj < 2; ++bj) rv[m][bj] = *(const u32x4*)(XB + o + bj * HALF); }
#pragma unroll
            for (int m = 0; m < 4; ++m) {
                const int row = rb0 + ai * HALF + wr * 64 + m * 16 + fr; const size_t o = (size_t)row * D + u.pn * BM + cin; float ss = 0.f;
#pragma unroll
                for (int bj = 0; bj < 2; ++bj) { const u32x4 r = rv[m][bj];
                    const f32x4 x0 = (f32x4){__uint_as_float(r.x << 16), __uint_as_float(r.x & 0xffff0000u), __uint_as_float(r.y << 16), __uint_as_float(r.y & 0xffff0000u)} + acc[ai][bj][m][0];
                    const f32x4 x1 = (f32x4){__uint_as_float(r.z << 16), __uint_as_float(r.z & 0xffff0000u), __uint_as_float(r.w << 16), __uint_as_float(r.w & 0xffff0000u)} + acc[ai][bj][m][1];
                    *(u32x4*)(XB + o + bj * HALF) = pack8(x0, x1);
                    if (X8) *(unsigned long long*)(X8 + o + bj * HALF) = pack8_fp8(x0, x1);
                    ss += (x0[0] * x0[0] + x0[1] * x0[1]) + (x0[2] * x0[2] + x0[3] * x0[3]) + (x1[0] * x1[0] + x1[1] * x1[1]) + (x1[2] * x1[2] + x1[3] * x1[3]); }
                ss += __shfl_xor(ss, 16); ss += __shfl_xor(ss, 32);
                if (fq == 0) SSQ[(size_t)row * 16 + u.pn * 4 + wc] = ss;
            }
            asm volatile("" ::: "memory");
        }
    }
};
struct EpiUp {
    static constexpr bool PERM = true; typedef Prep2 Prep;
    const float* ssq; bf16* ACT;
    __device__ __forceinline__ Prep prep_load(const Unit& u, int tid) const { Prep p; p.b = 0.f; p.a = row_rstd(ssq, u.pm * BM + (u.hm > 0 ? HALF : 0) + (tid & 255)); return p; }
    __device__ __forceinline__ void prep_store(const Prep& p, PG8_LAS float* tab, int par, int tid) const { tab[par * 512 + (tid & 255)] = p.a; }
    __device__ __forceinline__ void operator()(const f32x4 (&acc)[2][2][4][2], const Unit& u, const PG8_LAS float* tb, int wr, int wc, int fr, int fq) const {
        const int cin = wc * 32 + 8 * fq, rb0 = u.pm * BM + (u.hm > 0 ? HALF : 0); (void)rb0;
#pragma unroll
        for (int ai = 0; ai < 2; ++ai) if (ai == 0 || u.hm < 0)
#pragma unroll
            for (int m = 0; m < 4; ++m) {
                const int lr = ai * HALF + wr * 64 + m * 16 + fr, row = rb0 + lr; const float r = tb[lr];
                const f32x4 g0 = silu4(acc[ai][0][m][0] * r), g1 = silu4(acc[ai][0][m][1] * r);
                *(u32x4*)(ACT + (size_t)row * FF + u.pn * 128 + cin) = pack8(g0 * (acc[ai][1][m][0] * r), g1 * (acc[ai][1][m][1] * r));
            }
    }
};
struct EpiUpMoe {
    static constexpr bool PERM = true; typedef Prep2 Prep;
    const float* ssq; const int* rowinfo; const float* rowg; unsigned char* ACT;
    __device__ __forceinline__ Prep prep_load(const Unit& u, int tid) const { Prep p; p.a = 0.f; p.b = 0.f;
        { const int row = u.pm * BM + (u.hm > 0 ? HALF : 0) + (tid & 255); const int tok = rowinfo[row] & 0x3fff; p.a = row_rstd(ssq, tok); p.b = rowg[row] * p.a * 16.f; } return p; }
    __device__ __forceinline__ void prep_store(const Prep& p, PG8_LAS float* tab, int par, int tid) const { tab[par * 512 + (tid & 255)] = p.a; tab[par * 512 + 256 + (tid & 255)] = p.b; }
    __device__ __forceinline__ void operator()(const f32x4 (&acc)[2][2][4][2], const Unit& u, const PG8_LAS float* tb, int wr, int wc, int fr, int fq) const {
        const int cin = wc * 32 + 8 * fq, rb0 = u.pm * BM + (u.hm > 0 ? HALF : 0); (void)rb0;
#pragma unroll
        for (int ai = 0; ai < 2; ++ai) if (ai == 0 || u.hm < 0)
#pragma unroll
            for (int m = 0; m < 4; ++m) {
                const int lr = ai * HALF + wr * 64 + m * 16 + fr, row = rb0 + lr; const float r = tb[lr], gw = tb[256 + lr];
                const f32x4 g0 = silu4(acc[ai][0][m][0] * r), g1 = silu4(acc[ai][0][m][1] * r);
                *(unsigned long long*)(ACT + (size_t)row * FF + u.pn * 128 + cin) = pack8_fp8(g0 * (acc[ai][1][m][0] * gw), g1 * (acc[ai][1][m][1] * gw));
            }
    }
};
struct EpiDownMoe {
    static constexpr bool PERM = true; typedef Prep2 Prep;
    const int* rowinfo; bf16* YY;
    __device__ __forceinline__ Prep prep_load(const Unit& u, int tid) const { Prep p; p.b = 0.f; p.a = __int_as_float(rowinfo[u.pm * BM + (u.hm > 0 ? HALF : 0) + (tid & 255)]); return p; }
    __device__ __forceinline__ void prep_store(const Prep& p, PG8_LAS float* tab, int par, int tid) const { tab[par * 512 + (tid & 255)] = p.a; }
    __device__ __forceinline__ void operator()(const f32x4 (&acc)[2][2][4][2], const Unit& u, const PG8_LAS float* tb, int wr, int wc, int fr, int fq) const {
        const int cin = wc * 32 + 8 * fq, rb0 = u.pm * BM + (u.hm > 0 ? HALF : 0); (void)rb0;
#pragma unroll
        for (int ai = 0; ai < 2; ++ai) if (ai == 0 || u.hm < 0)
#pragma unroll
            for (int m = 0; m < 4; ++m) {
                const int lr = ai * HALF + wr * 64 + m * 16 + fr; const int info = __float_as_int(tb[lr]);
                if (info & 0x8000) { bf16* p = YY + (size_t)(info & 0x3fff) * 2048 + ((info >> 14) & 1) * 1024 + u.pn * BM + cin;
#pragma unroll
                    for (int bj = 0; bj < 2; ++bj) *(u32x4*)(p + bj * HALF) = pack8(acc[ai][bj][m][0], acc[ai][bj][m][1]); }
            }
    }
};
}

#define XB_TMO      128
#define XB_XCNT(j)  (256  + 64 * (j))
#define XB_XSUB(j)  (1280 + 64 * (j))
#define XB_XGEN(j)  (2304 + 64 * (j))
#define XB_TOP      3328
#define XB_TOPGEN   3392
#define XCD_BAR_WORDS 3456
#define XB_SPIN_CAP (1u << 18)
__device__ __forceinline__ unsigned xb_ld(unsigned* p)              { return __hip_atomic_load(p, __ATOMIC_RELAXED, __HIP_MEMORY_SCOPE_AGENT); }
__device__ __forceinline__ unsigned xb_add(unsigned* p, unsigned v) { return __hip_atomic_fetch_add(p, v, __ATOMIC_RELAXED, __HIP_MEMORY_SCOPE_AGENT); }
__device__ __forceinline__ unsigned xb_xcc_id() { return (unsigned)__builtin_amdgcn_s_getreg((3 << 11) | 20) & 0xFu; }
#define XB_SPIN(cond, bar) do { unsigned _sp = 0; while (cond) { __builtin_amdgcn_s_sleep(1); \
    if ((++_sp & 255u) == 0u) { if (xb_ld(&(bar)[XB_TMO])) break; if (_sp > XB_SPIN_CAP) { atomicAdd(&(bar)[XB_TMO], 1u); break; } } } } while (0)
struct XcdBarrier { unsigned* bar; unsigned x; volatile LAS unsigned* st; };
__device__ __forceinline__ XcdBarrier xcd_barrier_post(unsigned* bar, volatile LAS unsigned* st) {
    XcdBarrier b; b.bar = bar; b.x = xb_xcc_id(); b.st = st;
    if (threadIdx.x == 0) (void)xb_add(&bar[XB_XCNT(b.x)], 1u);
    return b;
}
__device__ __forceinline__ void xcd_barrier_complete(unsigned* bar, unsigned x, unsigned& nloc, unsigned& nx) {
    const unsigned G = gridDim.x * gridDim.y * gridDim.z;
    unsigned sum, cnt, mine, sp = 0u;
    for (;;) {
        sum = 0u; cnt = 0u; mine = 0u;
#pragma unroll
        for (unsigned j = 0; j < 16; ++j) { const unsigned c = xb_ld(&bar[XB_XCNT(j)]); sum += c; cnt += (c > 0u) ? 1u : 0u; mine = (j == x) ? c : mine; }
        if (sum == G) break;
        __builtin_amdgcn_s_sleep(1);
        if ((++sp & 255u) == 0u) { if (xb_ld(&bar[XB_TMO])) break; if (sp > XB_SPIN_CAP) { atomicAdd(&bar[XB_TMO], 1u); break; } }
    }
    nloc = mine > 0u ? mine : 1u; nx = cnt > 0u ? cnt : 1u;
}
__device__ __forceinline__ void xcd_barrier(const XcdBarrier& b) {
    asm volatile("s_waitcnt vmcnt(0)" ::: "memory");
    __syncthreads();
    if (threadIdx.x == 0) {
        unsigned* bar = b.bar;
        __builtin_amdgcn_s_waitcnt(0);
        unsigned nloc = b.st[0], nx = b.st[1];
        if (nloc == 0u) { xcd_barrier_complete(bar, b.x, nloc, nx); b.st[0] = nloc; b.st[1] = nx; }
        const unsigned old = xb_add(&bar[XB_XSUB(b.x)], 1u);
        const unsigned gen = old / nloc;
        if (old + 1u == (gen + 1u) * nloc) {
            __builtin_amdgcn_fence(__ATOMIC_RELEASE, "agent");
            asm volatile("s_waitcnt vmcnt(0)" ::: "memory");
            const unsigned og = xb_add(&bar[XB_TOP], 1u);
            const unsigned tg = og / nx;
            if (og + 1u == (tg + 1u) * nx) xb_add(&bar[XB_TOPGEN], 1u);
            else XB_SPIN(xb_ld(&bar[XB_TOPGEN]) == tg, bar);
            __builtin_amdgcn_fence(__ATOMIC_ACQUIRE, "agent");
            xb_add(&bar[XB_XGEN(b.x)], 1u);
            asm volatile("s_waitcnt vmcnt(0)" ::: "memory");
        } else {
            XB_SPIN(xb_ld(&bar[XB_XGEN(b.x)]) == gen, bar);
            __builtin_amdgcn_fence(__ATOMIC_ACQUIRE, "agent");
            asm volatile("s_waitcnt vmcnt(0)" ::: "memory");
        }
    }
    __syncthreads();
}

constexpr int NWAVES = 8, NTHR = 512;
constexpr int RING_BYTES = 131072, MISC_OFF = RING_BYTES, LDS_BYTES = 147456;
constexpr size_t MI_CNT = 1024 * 1024, MI_ROWINFO = 1040 * 1024, MI_ROWG = 1184 * 1024, MI_TILEE = 1328 * 1024;
constexpr int MAXTILES = 136;
constexpr size_t WS_ACTM = WS_WIN0;
constexpr size_t WS_Y1 = WS_XB;
static_assert(WS_ACTM + (size_t)MAXTILES * 256 * FF * 2 <= WS_END, "ACTM fits");

typedef short bf16x8 __attribute__((ext_vector_type(8)));

__device__ __forceinline__ void lds_barrier() { asm volatile("s_waitcnt lgkmcnt(0)" ::: "memory"); __builtin_amdgcn_s_barrier(); asm volatile("" ::: "memory"); }

struct GlaIn { v4u qv, kv, vv[2]; f32x4 lv[2]; };
__device__ __forceinline__ void gla_chunk_load(int g, GlaIn& in, const bf16* QSg, const bf16* KBg, const bf16* VBg, const float* LAg) {
    const int tid = opaque_tid(); const int bh = g >> 6, n = g & 63, b = bh >> 2, h = bh & 3; const size_t row0 = (size_t)b * T + n * CHUNK;
    const int r = tid >> 3, s8 = (tid & 7) * 8; const size_t go = (row0 + r) * KEY + h * 64 + s8;
    in.qv = *(const v4u*)(QSg + go); in.kv = *(const v4u*)(KBg + go);
#pragma unroll
    for (int k = 0; k < 2; ++k) { const int e = tid + 512 * k, rr = e >> 4; in.lv[k] = *(const f32x4*)(LAg + (row0 + rr) * KEY + h * 64 + (e & 15) * 4); in.vv[k] = *(const v4u*)(VBg + (row0 + rr) * VAL + h * 128 + (e & 15) * 8); }
}
__device__ __forceinline__ void gla_chunk_unit(int g, const GlaIn& in, LAS unsigned char* lds, bf16* QTg, bf16* OIg, float* DSg, float* DECg) {
    const int tid = opaque_tid(), lane = tid & 63, wid = __builtin_amdgcn_readfirstlane(tid >> 6);
    const int bh = g >> 6, n = g & 63, b = bh >> 2, h = bh & 3; const size_t row0 = (size_t)b * T + n * CHUNK;
    LAS float* LAf = (LAS float*)lds; LAS bf16* Qr = (LAS bf16*)(lds + 16384); LAS bf16* Kr = (LAS bf16*)(lds + 25600); LAS bf16* Vr = (LAS bf16*)(lds + 34816); LAS float* SEG = (LAS float*)(lds + 52224);
    LAS bf16* QTl = (LAS bf16*)(lds + 54272); LAS bf16* KTl = (LAS bf16*)(lds + 63488); LAS bf16* KHT = (LAS bf16*)(lds + 72704); LAS bf16* VT = (LAS bf16*)(lds + 81920); LAS bf16* P = (LAS bf16*)(lds + 100352);
    { const int r = tid >> 3, s8 = (tid & 7) * 8;
      *(LAS v4u*)(Qr + r * 72 + s8) = in.qv; *(LAS v4u*)(Kr + r * 72 + s8) = in.kv;
#pragma unroll
      for (int k = 0; k < 2; ++k) { const int e = tid + 512 * k, rr = e >> 4; *(LAS f32x4*)(LAf + rr * 64 + (e & 15) * 4) = in.lv[k]; *(LAS v4u*)(Vr + rr * 136 + (e & 15) * 8) = in.vv[k]; } }
    lds_barrier();
    const int d = lane, seg = wid;
    float c[8];
    { float run = 0.f;
#pragma unroll
      for (int i = 0; i < 8; ++i) { run += LAf[(seg * 8 + i) * 64 + d]; c[i] = run; }
      SEG[seg * 64 + d] = run; }
    { const int v = tid & 127, jg = tid >> 7; unsigned w[8];
#pragma unroll
      for (int i = 0; i < 8; ++i) w[i] = (unsigned)Vr[(jg * 16 + 2 * i) * 136 + v] | ((unsigned)Vr[(jg * 16 + 2 * i + 1) * 136 + v] << 16);
      *(LAS v4u*)(VT + v * 72 + jg * 16) = (v4u){w[0], w[1], w[2], w[3]}; *(LAS v4u*)(VT + v * 72 + jg * 16 + 8) = (v4u){w[4], w[5], w[6], w[7]}; }
    lds_barrier();
    { float off = 0.f, tot = 0.f;
#pragma unroll
      for (int s2 = 0; s2 < 8; ++s2) { const float v = SEG[s2 * 64 + d]; tot += v; off += (s2 < seg) ? v : 0.f; }
      if (seg == 0) DECg[(size_t)g * 64 + d] = __expf(tot);
      unsigned kh[4];
#pragma unroll
      for (int i = 0; i < 8; ++i) { const int ii = seg * 8 + i; const float bb = off + c[i]; const float qv = bf2f(Qr[ii * 72 + d]), kv = bf2f(Kr[ii * 72 + d]);
          QTl[ii * 72 + d] = (bf16)f2bf(qv * __expf(bb)); KTl[ii * 72 + d] = (bf16)f2bf(kv * __expf(-bb));
          const unsigned hv = f2bf(kv * __expf(tot - bb)); if (i & 1) kh[i >> 1] |= hv << 16; else kh[i >> 1] = hv; }
      *(LAS v4u*)(KHT + d * 72 + seg * 8) = (v4u){kh[0], kh[1], kh[2], kh[3]}; }
    lds_barrier();
    { const int r = tid >> 3, s8 = (tid & 7) * 8; *(v4u*)(QTg + (row0 + r) * KEY + h * 64 + s8) = *(const LAS v4u*)(QTl + r * 72 + s8); }
    const int fr = lane & 15, fq = lane >> 4;
    { const int it = wid >> 1;
      const bf16x8 qb0 = *(const LAS bf16x8*)(QTl + (it * 16 + fr) * 72 + fq * 8), qb1 = *(const LAS bf16x8*)(QTl + (it * 16 + fr) * 72 + 32 + fq * 8);
#pragma unroll
      for (int jj = 0; jj < 2; ++jj) { const int jt = 2 * (wid & 1) + jj;
          const bf16x8 ka0 = *(const LAS bf16x8*)(KTl + (jt * 16 + fr) * 72 + fq * 8), ka1 = *(const LAS bf16x8*)(KTl + (jt * 16 + fr) * 72 + 32 + fq * 8);
          f32x4 a = (f32x4){0.f, 0.f, 0.f, 0.f};
          a = __builtin_amdgcn_mfma_f32_16x16x32_bf16(ka0, qb0, a, 0, 0, 0); a = __builtin_amdgcn_mfma_f32_16x16x32_bf16(ka1, qb1, a, 0, 0, 0);
          const int i = it * 16 + fr, j0 = jt * 16 + 4 * fq;
          unsigned long long w = 0ull;
#pragma unroll
          for (int r = 0; r < 4; ++r) { const float v = (j0 + r <= i) ? a[r] : 0.f; w |= (unsigned long long)f2bf(v) << (16 * r); }
          *(LAS unsigned long long*)(P + i * 72 + j0) = w; } }
    lds_barrier();
    { const int xt = wid & 3;
      const bf16x8 pb0 = *(const LAS bf16x8*)(P + (xt * 16 + fr) * 72 + fq * 8), pb1 = *(const LAS bf16x8*)(P + (xt * 16 + fr) * 72 + 32 + fq * 8);
      const bf16x8 ha0 = *(const LAS bf16x8*)(KHT + (xt * 16 + fr) * 72 + fq * 8), ha1 = *(const LAS bf16x8*)(KHT + (xt * 16 + fr) * 72 + 32 + fq * 8);
#pragma unroll
      for (int vv = 0; vv < 4; ++vv) { const int vt = 4 * (wid >> 2) + vv;
          const bf16x8 va0 = *(const LAS bf16x8*)(VT + (vt * 16 + fr) * 72 + fq * 8), va1 = *(const LAS bf16x8*)(VT + (vt * 16 + fr) * 72 + 32 + fq * 8);
          f32x4 o = (f32x4){0.f, 0.f, 0.f, 0.f};
          o = __builtin_amdgcn_mfma_f32_16x16x32_bf16(va0, pb0, o, 0, 0, 0); o = __builtin_amdgcn_mfma_f32_16x16x32_bf16(va1, pb1, o, 0, 0, 0);
          *(unsigned long long*)(OIg + (row0 + xt * 16 + fr) * VAL + h * 128 + vt * 16 + 4 * fq) = (unsigned long long)pk2(o[0], o[1]) | ((unsigned long long)pk2(o[2], o[3]) << 32);
          f32x4 s = (f32x4){0.f, 0.f, 0.f, 0.f};
          s = __builtin_amdgcn_mfma_f32_16x16x32_bf16(ha0, va0, s, 0, 0, 0); s = __builtin_amdgcn_mfma_f32_16x16x32_bf16(ha1, va1, s, 0, 0, 0);
          *(f32x4*)(DSg + ((size_t)g * 128 + vt * 16 + fr) * 64 + xt * 16 + 4 * fq) = s; } }
    lds_barrier();
}

__device__ __forceinline__ void conv_unit(int cu, LAS unsigned char* lds, const bf16* UBg, const float* cw, const float* cb, const float* cnw, const float* cnb, bf16* MIXg) {
    const int tid = opaque_tid(), c = tid; const int row0 = cu * 32, t0 = row0 & (T - 1);
    LAS bf16* U = (LAS bf16*)lds; LAS float* Y = (LAS float*)(lds + 63488); LAS float* STAT = (LAS float*)(lds + 129536);
    { v4u uv[8];
#pragma unroll
      for (int k = 0; k < 8; ++k) { const int e = min(tid + 512 * k, 62 * 64 - 1), r = e >> 6; const bool ok = (t0 + r >= 30);
          uv[k] = *(const v4u*)(UBg + (size_t)(ok ? row0 - 30 + r : row0) * CCH + (e & 63) * 8); if (!ok) uv[k] = (v4u){0u, 0u, 0u, 0u}; }
#pragma unroll
      for (int k = 0; k < 8; ++k) { const int e = min(tid + 512 * k, 62 * 64 - 1); *(LAS v4u*)(U + (size_t)e * 8) = uv[k]; } }
    float w[CW];
#pragma unroll
    for (int k = 0; k < CW; ++k) w[k] = cw[k * CCH + c];
    float y[32]; const float bias = cb[c];
#pragma unroll
    for (int i = 0; i < 32; ++i) y[i] = bias;
    lds_barrier();
    float uu[62];
#pragma unroll
    for (int p = 0; p < 62; ++p) uu[p] = bf2f(U[p * 512 + c]);
#pragma clang loop unroll(full)
    for (int k = 0; k < CW; ++k) {
#pragma clang loop unroll(full)
        for (int i = 0; i < 32; ++i) y[i] = fmaf(uu[i + k], w[k], y[i]);
    }
#pragma unroll
    for (int i = 0; i < 32; ++i) Y[i * 516 + c] = y[i];
    lds_barrier();
    { const int tt = tid >> 4, part = tid & 15; float s = 0.f, q = 0.f;
#pragma unroll
      for (int k = 0; k < 32; ++k) { const float v = Y[tt * 516 + part * 32 + ((k + part) & 31)]; s += v; q += v * v; }
#pragma unroll
      for (int o = 1; o < 16; o <<= 1) { s += __shfl_xor(s, o); q += __shfl_xor(q, o); }
      if (part == 0) { const float mean = s * (1.f / CCH); const float var = fmaxf(q * (1.f / CCH) - mean * mean, 0.f); STAT[tt * 2] = mean; STAT[tt * 2 + 1] = rsqrtf(var + EPS); } }
    lds_barrier();
    const float gw = cnw[c], gb = cnb[c];
#pragma unroll
    for (int i = 0; i < 32; ++i) { const float z = (y[i] - STAT[i * 2]) * STAT[i * 2 + 1] * gw + gb; U[i * 512 + c] = (bf16)f2bf(z * __builtin_amdgcn_rcpf(1.f + __expf(-z))); }
    lds_barrier();
#pragma unroll
    for (int k = 0; k < 4; ++k) { const int e = tid + 512 * k, r = e >> 6; *(v4u*)(MIXg + (size_t)(row0 + r) * D + 512 + (e & 63) * 8) = *(const LAS v4u*)(U + (size_t)e * 8); }
    lds_barrier();
}

__device__ __forceinline__ void gla_out_unit(int g, LAS unsigned char* lds, const bf16* QTg, const bf16* SP, const bf16* OI, const bf16* SG, const float* gnw, bf16* MIX) {
    const int tid = opaque_tid(), lane = tid & 63, wid = __builtin_amdgcn_readfirstlane(tid >> 6);
    const int bh = g >> 6, n = g & 63, b = bh >> 2, h = bh & 3; const size_t row0 = (size_t)b * T + n * CHUNK;
    LAS bf16* QTl = (LAS bf16*)lds; LAS bf16* ST = (LAS bf16*)(lds + 9216); LAS float* SS = (LAS float*)(lds + 27648);
    { const int i = tid >> 3, ds = (tid & 7) * 8; *(LAS v4u*)(QTl + i * 72 + ds) = *(const v4u*)(QTg + (row0 + i) * KEY + h * 64 + ds); }
#pragma unroll
    for (int k = 0; k < 2; ++k) { const int e = tid + k * 512, v = e >> 3, ds = (e & 7) * 8; *(LAS v4u*)(ST + v * 72 + ds) = *(const v4u*)(SP + ((size_t)g * 128 + v) * 64 + ds); }
    lds_barrier();
    const int fr = lane & 15, fq = lane >> 4, it = wid & 3;
    const bf16x8 qb0 = *(const LAS bf16x8*)(QTl + (it * 16 + fr) * 72 + fq * 8), qb1 = *(const LAS bf16x8*)(QTl + (it * 16 + fr) * 72 + 32 + fq * 8);
    f32x4 o[4]; float ss = 0.f; const size_t rowi = row0 + it * 16 + fr; unsigned long long sgv[4]; f32x4 gwv[4];
#pragma unroll
    for (int vv = 0; vv < 4; ++vv) { const int v0 = (4 * (wid >> 2) + vv) * 16 + 4 * fq; sgv[vv] = *(const unsigned long long*)(SG + rowi * VAL + h * 128 + v0); gwv[vv] = *(const f32x4*)(gnw + v0); }
#pragma unroll
    for (int vv = 0; vv < 4; ++vv) { const int vt = 4 * (wid >> 2) + vv;
        const bf16x8 sa0 = *(const LAS bf16x8*)(ST + (vt * 16 + fr) * 72 + fq * 8), sa1 = *(const LAS bf16x8*)(ST + (vt * 16 + fr) * 72 + 32 + fq * 8);
        f32x4 a = (f32x4){0.f, 0.f, 0.f, 0.f};
        a = __builtin_amdgcn_mfma_f32_16x16x32_bf16(sa0, qb0, a, 0, 0, 0); a = __builtin_amdgcn_mfma_f32_16x16x32_bf16(sa1, qb1, a, 0, 0, 0);
        const unsigned long long oi = *(const unsigned long long*)(OI + rowi * VAL + h * 128 + vt * 16 + 4 * fq);
        a[0] += __uint_as_float((unsigned)(oi << 16)); a[1] += __uint_as_float((unsigned)oi & 0xffff0000u); a[2] += __uint_as_float((unsigned)(oi >> 32) << 16); a[3] += __uint_as_float((unsigned)(oi >> 32) & 0xffff0000u);
        o[vv] = a; ss += (a[0] * a[0] + a[1] * a[1]) + (a[2] * a[2] + a[3] * a[3]); }
    ss += __shfl_xor(ss, 16); ss += __shfl_xor(ss, 32);
    if (fq == 0) SS[(wid >> 2) * 64 + it * 16 + fr] = ss;
    lds_barrier();
    const float r = rsqrtf((SS[it * 16 + fr] + SS[64 + it * 16 + fr]) * (1.f / DV) + EPS);
#pragma unroll
    for (int vv = 0; vv < 4; ++vv) { const int v0 = (4 * (wid >> 2) + vv) * 16 + 4 * fq; const f32x4 gw = gwv[vv];
        const unsigned long long sg = sgv[vv];
        const float s0 = __uint_as_float((unsigned)(sg << 16)), s1 = __uint_as_float((unsigned)sg & 0xffff0000u), s2 = __uint_as_float((unsigned)(sg >> 32) << 16), s3 = __uint_as_float((unsigned)(sg >> 32) & 0xffff0000u);
        *(unsigned long long*)(MIX + rowi * D + h * 128 + v0) = (unsigned long long)pk2(o[vv][0] * r * gw[0] * s0, o[vv][1] * r * gw[1] * s1) | ((unsigned long long)pk2(o[vv][2] * r * gw[2] * s2, o[vv][3] * r * gw[3] * s3) << 32); }
    lds_barrier();
}

struct Args { Inputs I; float* out; unsigned char* ws; int ph_lo, ph_hi; };
__global__ void __launch_bounds__(NTHR, 2) mk_fwd(Args args) {
    extern __shared__ __attribute__((aligned(16))) unsigned char lds_raw[];
    LAS unsigned char* lds = (LAS unsigned char*)lds_raw;
    const int G = gridDim.x, bx = blockIdx.x;
#define PH_IDS const int tid = opaque_tid(), lane = tid & 63, wave = __builtin_amdgcn_readfirstlane(tid >> 6); (void)lane; (void)wave
    unsigned char* ws = args.ws; const Inputs& I = args.I; float* XA = args.out;
#define XB ((bf16*)(ws + WS_XB))
#define QS ((bf16*)(ws + WS_QS))
#define KB ((bf16*)(ws + WS_KB))
#define VB ((bf16*)(ws + WS_VB))
#define SG ((bf16*)(ws + WS_SG))
#define UB ((bf16*)(ws + WS_UB))
#define MIX ((bf16*)(ws + WS_MIX))
#define ACT ((bf16*)(ws + WS_ACT))
#define QT ((bf16*)(ws + WS_QT))
#define OI ((bf16*)(ws + WS_OI))
#define SP ((bf16*)(ws + WS_SP))
#define ACTM ((bf16*)(ws + WS_ACTM))
#define Y1 ((bf16*)(ws + WS_Y1))
#define SSQ ((float*)(ws + WS_SSQ))
#define LA ((float*)(ws + WS_LA))
#define DS ((float*)(ws + WS_DS))
#define DEC ((float*)(ws + WS_MISC + MI_DEC))
#define ROWG ((float*)(ws + WS_MISC + MI_ROWG))
#define SEL ((int*)(ws + WS_MISC + MI_SEL))
#define CNT ((int*)(ws + WS_MISC + MI_CNT))
#define ROWINFO ((int*)(ws + WS_MISC + MI_ROWINFO))
#define TILEE ((int*)(ws + WS_MISC + MI_TILEE))
    const int lo = args.ph_lo, hi = args.ph_hi;
    if (threadIdx.x < 4) ((LAS unsigned*)(lds + MISC_OFF))[threadIdx.x] = 0u;
    __syncthreads();
    XcdBarrier bar; bar.bar = (unsigned*)(ws + WS_CTL) + 4096; bar.x = 0; bar.st = nullptr;
    if (hi - lo > 1) bar = xcd_barrier_post((unsigned*)(ws + WS_CTL) + 4096, (volatile LAS unsigned*)(lds + MISC_OFF));
#ifndef PHMASK
#define PHMASK 0x3ffff
#endif
#define IN(k) (((PHMASK >> ((k) >= 8 && (k) <= 12 ? (k) - 7 : (k))) & 1) && lo <= (k) && (k) < hi)
#define SEAM(k) do { if (IN(k) && IN((k) + 1)) xcd_barrier(bar); } while (0)

    if (IN(0)) { PH_IDS;
        LAS float* scr = (LAS float*)(lds + wave * 16384); const int gw = bx * NWAVES + wave, NGW = G * NWAVES;
        cvt_all(I, ws, gw, NGW, scr, lane);
        for (int idx = bx * NTHR + tid; idx < 2 * 256 * 1024; idx += G * NTHR) cvt_gate_elem(I, ws, idx);
        for (int m = gw; m < M; m += NGW) row_to_xb(I.x + (size_t)m * D, XB + (size_t)m * D, SSQ + (size_t)m * 16, lane);
        __syncthreads();
    }
    SEAM(0);
    for (int l = 0; l < 2; ++l) {
        const int pb = 1 + 7 * l;
        const bf16* Win = (const bf16*)(ws + (l ? WS_WIN1 : WS_WIN0)); const bf16* Wout = (const bf16*)(ws + (l ? WS_WOUT1 : WS_WOUT0));
        if (IN(pb)) {
            pg8::StaticOrder<NIN / 256> S; S.init(M / 256, G, bx, Win);
            pg8::EpiIn E{SSQ, I.b_gate + l * KEY, QS, KB, VB, SG, UB, LA};
            pg8::gemm_phase<pg8::EpiIn, pg8::StaticOrder<NIN / 256>, true, true>(lds, (LAS float*)(lds + MISC_OFF + 64), XB, D, S, E);
        }
        SEAM(pb);
        if (IN(pb + 1)) {
            GlaIn gin; if (bx < 1024) gla_chunk_load(bx, gin, QS, KB, VB, LA);
            for (int u = bx; u < 1024 + 512; u += G) {
                if (u < 1024) { GlaIn gnx = gin; if (u + G < 1024) gla_chunk_load(u + G, gnx, QS, KB, VB, LA);
                    gla_chunk_unit(u, gin, lds, QT, OI, DS, DEC); gin = gnx; }
                else conv_unit(u - 1024, lds, UB, I.conv_w + l * CW * CCH, I.conv_b + l * CCH, I.cn_w + l * CCH, I.cn_b + l * CCH, MIX);
            }
        }
        SEAM(pb + 1);
        if (IN(pb + 2)) { PH_IDS;
            for (int idx = bx * NTHR + tid; idx < NB * H * DV * DK; idx += G * NTHR) {
                const int bh = idx >> 13, vd = idx & 8191, d = idx & 63; float S = 0.f;
                const float* dsp = DS + (size_t)bh * 64 * 8192 + vd; const float* dcp = DEC + (size_t)bh * 64 * 64 + d; bf16* spp = SP + (size_t)bh * 64 * 8192 + vd;
                for (int nb = 0; nb < NCH; nb += 16) {
                    float dv[16], av[16];
#pragma unroll
                    for (int i = 0; i < 16; ++i) { dv[i] = dsp[(size_t)(nb + i) * 8192]; av[i] = dcp[(nb + i) * 64]; }
#pragma unroll
                    for (int i = 0; i < 16; ++i) { spp[(size_t)(nb + i) * 8192] = (bf16)f2bf(S); S = av[i] * S + dv[i]; }
                }
            }
        }
        SEAM(pb + 2);
        if (IN(pb + 3)) {
            for (int u = bx; u < 1024; u += G) gla_out_unit(u, lds, QT, SP, OI, SG, I.gla_norm_w + l * DV, MIX);
        }
        SEAM(pb + 3);
        if (IN(pb + 4)) {
            pg8::StaticOrder<D / 256> S; S.init(M / 256, G, bx, Wout);
            pg8::EpiRes E{XB, SSQ, l == 1 ? ws + WS_XB8 : nullptr};
            pg8::gemm_phase<pg8::EpiRes, pg8::StaticOrder<D / 256>, true, true>(lds, (LAS float*)(lds + MISC_OFF + 64), MIX, D, S, E);
        }
        SEAM(pb + 4);
        if (l == 0) {
            if (IN(6)) {
                pg8::StaticOrder<NGU / 256, false> S; S.init(M / 256, G, bx, (const bf16*)(ws + WS_WDGU));
                pg8::EpiUp E{SSQ, ACT};
                pg8::gemm_phase<pg8::EpiUp, pg8::StaticOrder<NGU / 256, false>, true, true>(lds, (LAS float*)(lds + MISC_OFF + 64), XB, D, S, E);
            }
            SEAM(6);
            if (IN(7)) {
                pg8::StaticOrder<D / 256> S; S.init(M / 256, G, bx, (const bf16*)(ws + WS_WDD));
                pg8::EpiRes E{XB, SSQ, nullptr};
                pg8::gemm_phase<pg8::EpiRes, pg8::StaticOrder<D / 256>, true, true>(lds, (LAS float*)(lds + MISC_OFF + 64), ACT, FF, S, E);
            }
            SEAM(7);
        }
    }
    if (IN(13)) { PH_IDS;
        LAS int* sel = (LAS int*)lds;
        f32x4 wq[4][4][2];
#pragma unroll
        for (int j = 0; j < 4; ++j)
#pragma unroll
            for (int c = 0; c < 4; ++c) { const int k = 256 * j + 4 * lane + c; const float lw = I.ln2_w[D + k]; const f32x4* wp = (const f32x4*)(I.w_router + (size_t)k * NE); wq[j][c][0] = wp[0] * lw; wq[j][c][1] = wp[1] * lw; }
        for (int rb = bx; rb < M / 64; rb += G) {
            unsigned long long xw[8][4];
#pragma unroll
            for (int k8 = 0; k8 < 8; ++k8) { const unsigned long long* xr = (const unsigned long long*)(XB + (size_t)(rb * 64 + wave * 8 + k8) * D) + lane;
#pragma unroll
                for (int j = 0; j < 4; ++j) xw[k8][j] = xr[64 * j]; }
            float val[9][8];
#pragma unroll
            for (int k8 = 0; k8 < 8; ++k8) {
                f32x4 l0 = (f32x4){0.f, 0.f, 0.f, 0.f}, l1 = l0; float ss = 0.f;
#pragma unroll
                for (int j = 0; j < 4; ++j) { const unsigned long long w8 = xw[k8][j];
                    const float xe[4] = {__uint_as_float((unsigned)(w8 << 16)), __uint_as_float((unsigned)w8 & 0xffff0000u), __uint_as_float((unsigned)(w8 >> 32) << 16), __uint_as_float((unsigned)(w8 >> 32) & 0xffff0000u)};
#pragma unroll
                    for (int c = 0; c < 4; ++c) { const float x = xe[c]; ss += x * x; l0 += wq[j][c][0] * x; l1 += wq[j][c][1] * x; } }
#pragma unroll
                for (int e = 0; e < 4; ++e) { val[e][k8] = l0[e]; val[4 + e][k8] = l1[e]; }
                val[8][k8] = ss;
            }
            const bool b5 = (lane & 32) != 0, b4 = (lane & 16) != 0, b3 = (lane & 8) != 0;
            float v1[9];
#pragma unroll
            for (int q = 0; q < 9; ++q) { float v4[4], v2[2];
#pragma unroll
                for (int t = 0; t < 4; ++t) { const float keep = b5 ? val[q][t + 4] : val[q][t], send = b5 ? val[q][t] : val[q][t + 4]; v4[t] = keep + __shfl_xor(send, 32); }
#pragma unroll
                for (int t = 0; t < 2; ++t) { const float keep = b4 ? v4[t + 2] : v4[t], send = b4 ? v4[t] : v4[t + 2]; v2[t] = keep + __shfl_xor(send, 16); }
                const float keep = b3 ? v2[1] : v2[0], send = b3 ? v2[0] : v2[1]; float x = keep + __shfl_xor(send, 8);
                x += __shfl_xor(x, 4); x += __shfl_xor(x, 2); x += __shfl_xor(x, 1); v1[q] = x; }
            { const int tk = lane >> 3, m = rb * 64 + wave * 8 + tk; const float r = rsqrtf(v1[8] * (1.f / D) + EPS);
                float lg[NE];
#pragma unroll
                for (int e = 0; e < NE; ++e) lg[e] = v1[e] * r;
                int e1 = 0; float vv1 = lg[0];
#pragma unroll
                for (int e = 1; e < NE; ++e) if (lg[e] > vv1) { vv1 = lg[e]; e1 = e; }
                int e2 = -1; float vv2 = -3.0e38f;
#pragma unroll
                for (int e = 0; e < NE; ++e) if (e != e1 && lg[e] > vv2) { vv2 = lg[e]; e2 = e; }
                const float p2 = __expf(vv2 - vv1), g1 = 1.f / (1.f + p2), g2 = p2 / (1.f + p2);
                if ((lane & 7) == 0) { SEL[m * 4 + 0] = e1; SEL[m * 4 + 1] = e2; SEL[m * 4 + 2] = __float_as_int(g1); SEL[m * 4 + 3] = __float_as_int(g2); sel[(wave * 8 + tk) * 2] = e1; sel[(wave * 8 + tk) * 2 + 1] = e2; }
            }
            __syncthreads();
            if (wave == 0) { const int e1 = sel[lane * 2], e2 = sel[lane * 2 + 1];
#pragma unroll
                for (int e = 0; e < NE; ++e) { const int cnt = __popcll(__ballot(e1 == e)) + __popcll(__ballot(e2 == e)); if (lane == 0) CNT[rb * NE + e] = cnt; } }
            __syncthreads();
        }
    }
    SEAM(13);
    if (IN(14)) { PH_IDS;
        LAS int* tab = (LAS int*)lds;
        for (int rb = bx; rb < M / 64; rb += G) {
            if (wave == 0) {
#pragma unroll
                for (int e = 0; e < NE; ++e) { int tot = 0, pre = 0;
#pragma unroll
                    for (int q = 0; q < 4; ++q) { const int r2 = lane + 64 * q; const int c = CNT[r2 * NE + e]; tot += c; pre += (r2 < rb) ? c : 0; }
#pragma unroll
                    for (int o = 1; o < 64; o <<= 1) { tot += __shfl_xor(tot, o); pre += __shfl_xor(pre, o); }
                    if (lane == 0) { tab[e] = tot; tab[16 + e] = pre; } }
                asm volatile("s_waitcnt lgkmcnt(0)" ::: "memory");
                if (lane == 0) { int off = 0;
                    for (int e = 0; e < NE; ++e) { tab[8 + e] = off; tab[16 + e] += off; off += ((tab[e] + 255) >> 8) << 8; }
                    tab[24] = off >> 8; }
                asm volatile("s_waitcnt lgkmcnt(0)" ::: "memory");
                const int m = rb * 64 + lane; const int e1 = SEL[m * 4], e2 = SEL[m * 4 + 1]; const float g1 = __int_as_float(SEL[m * 4 + 2]), g2 = __int_as_float(SEL[m * 4 + 3]);
                const unsigned long long lt = (1ull << lane) - 1ull;
#pragma unroll
                for (int e = 0; e < NE; ++e) { const unsigned long long m1 = __ballot(e1 == e), m2 = __ballot(e2 == e); const int base = tab[16 + e];
                    if (e1 == e) { const int pos = base + __popcll(m1 & lt); ROWINFO[pos] = m | 0x8000; ROWG[pos] = g1; }
                    if (e2 == e) { const int pos = base + __popcll(m1) + __popcll(m2 & lt); ROWINFO[pos] = m | 0x4000 | 0x8000; ROWG[pos] = g2; } }
                if (rb < NE) { const int tot = tab[rb], off = tab[8 + rb], pad = ((tot + 255) >> 8) << 8;
                    for (int p = tot + lane; p < pad; p += 64) { ROWINFO[off + p] = 0; ROWG[off + p] = 0.f; }
                    for (int tI = lane; tI < (pad >> 8); tI += 64) TILEE[(off >> 8) + tI] = rb; }
                if (rb == 0 && lane == 0) TILEE[255] = tab[24];
            }
            __syncthreads();
        }
    }
    SEAM(14);
    if (IN(15)) {
        const int NT = __builtin_amdgcn_readfirstlane(__hip_atomic_load(TILEE + 255, __ATOMIC_RELAXED, __HIP_MEMORY_SCOPE_AGENT));
        LAS int* tile_l = (LAS int*)(lds + MISC_OFF + 8192);
        if (threadIdx.x < MAXTILES) tile_l[threadIdx.x] = TILEE[threadIdx.x];
        __syncthreads();
        pg8::MoeOrder<true, NGU / 256, false> S; S.init(NT, G, bx, ws + WS_WMGU, (size_t)NGU * D, tile_l, ROWINFO);
        pg8::EpiUpMoe E{SSQ, ROWINFO, ROWG, ws + WS_ACTM};
        pg8::gemm_phase<pg8::EpiUpMoe, pg8::MoeOrder<true, NGU / 256, false>, true, true, true, 0x79797979, 0x7f7f7f7f>(lds, (LAS float*)(lds + MISC_OFF + 64), ws + WS_XB8, D, S, E);
    }
    SEAM(15);
    if (IN(16)) {
        const int NT = __builtin_amdgcn_readfirstlane(__hip_atomic_load(TILEE + 255, __ATOMIC_RELAXED, __HIP_MEMORY_SCOPE_AGENT));
        LAS int* tile_l = (LAS int*)(lds + MISC_OFF + 8192);
        if (threadIdx.x < MAXTILES) tile_l[threadIdx.x] = TILEE[threadIdx.x];
        __syncthreads();
        pg8::MoeOrder<false, D / 256, false> S; S.init(NT, G, bx, ws + WS_WMD, (size_t)D * FF, tile_l, ROWINFO);
        pg8::EpiDownMoe E{ROWINFO, (bf16*)XA};
        pg8::gemm_phase<pg8::EpiDownMoe, pg8::MoeOrder<false, D / 256, false>, true, true, true, 0x79797979, 0x7b7b7b7b>(lds, (LAS float*)(lds + MISC_OFF + 64), ws + WS_ACTM, FF, S, E);
    }
    SEAM(16);
    if (IN(17)) { PH_IDS;
        const int gw = bx * NWAVES + wave, NGW = G * NWAVES;
        f32x4 wv[4];
#pragma unroll
        for (int j = 0; j < 4; ++j) wv[j] = ((const f32x4*)I.final_w)[lane + 64 * j];
        unsigned long long a0[4], a1[4], a2[4];
        int m = gw;
        if (m < M) { const unsigned long long* y0 = (const unsigned long long*)((const bf16*)XA + (size_t)m * 2048) + lane; const unsigned long long* xb = (const unsigned long long*)(XB + (size_t)m * D) + lane;
#pragma unroll
            for (int j = 0; j < 4; ++j) { a0[j] = y0[64 * j]; a1[j] = y0[256 + 64 * j]; a2[j] = xb[64 * j]; } }
        while (m < M) { const int mn = m + NGW; unsigned long long b0[4], b1[4], b2[4];
            if (mn < M) { const unsigned long long* y0 = (const unsigned long long*)((const bf16*)XA + (size_t)mn * 2048) + lane; const unsigned long long* xb = (const unsigned long long*)(XB + (size_t)mn * D) + lane;
#pragma unroll
                for (int j = 0; j < 4; ++j) { b0[j] = y0[64 * j]; b1[j] = y0[256 + 64 * j]; b2[j] = xb[64 * j]; } }
            f32x4 v[4]; float s = 0.f;
#pragma unroll
            for (int j = 0; j < 4; ++j) {
                v[j][0] = __uint_as_float((unsigned)(a0[j] << 16)) + __uint_as_float((unsigned)(a1[j] << 16)) + __uint_as_float((unsigned)(a2[j] << 16));
                v[j][1] = __uint_as_float((unsigned)a0[j] & 0xffff0000u) + __uint_as_float((unsigned)a1[j] & 0xffff0000u) + __uint_as_float((unsigned)a2[j] & 0xffff0000u);
                v[j][2] = __uint_as_float((unsigned)(a0[j] >> 32) << 16) + __uint_as_float((unsigned)(a1[j] >> 32) << 16) + __uint_as_float((unsigned)(a2[j] >> 32) << 16);
                v[j][3] = __uint_as_float((unsigned)(a0[j] >> 32) & 0xffff0000u) + __uint_as_float((unsigned)(a1[j] >> 32) & 0xffff0000u) + __uint_as_float((unsigned)(a2[j] >> 32) & 0xffff0000u);
                s += (v[j].x * v[j].x + v[j].y * v[j].y) + (v[j].z * v[j].z + v[j].w * v[j].w); }
            const float r = rsqrtf(wave_sum(s) * (1.f / D) + EPS);
            f32x4* xr = (f32x4*)(XA + (size_t)m * D) + lane;
#pragma unroll
            for (int j = 0; j < 4; ++j) xr[64 * j] = v[j] * r * wv[j];
#pragma unroll
            for (int j = 0; j < 4; ++j) { a0[j] = b0[j]; a1[j] = b1[j]; a2[j] = b2[j]; }
            m = mn; }
    }
#undef IN
#undef SEAM
#undef PH_IDS
#undef XB
#undef QS
#undef KB
#undef VB
#undef SG
#undef UB
#undef MIX
#undef ACT
#undef QT
#undef OI
#undef SP
#undef ACTM
#undef Y1
#undef SSQ
#undef LA
#undef DS
#undef DEC
#undef ROWG
#undef SEL
#undef CNT
#undef ROWINFO
#undef TILEE
}
extern "C" void kernel_launch(void* const* d_in, const int* in_sizes, int n_in, void* d_out, int out_size, void* d_ws, size_t ws_size, hipStream_t stream) {
    static int grid = 0;
    if (grid == 0) {
        if (n_in != 20 || in_sizes[0] != M * D || out_size != M * D || ws_size < WS_END) { fprintf(stderr, "kernel_launch: unexpected shapes/workspace (n_in %d, ws %zu, need %zu)\n", n_in, ws_size, (size_t)WS_END); grid = -1; return; }
        int dev = 0, cus = 0, per_cu = 0;
        if (hipGetDevice(&dev) != hipSuccess || hipDeviceGetAttribute(&cus, hipDeviceAttributeMultiprocessorCount, dev) != hipSuccess) { grid = -1; return; }
        if (hipFuncSetAttribute((const void*)mk_fwd, hipFuncAttributeMaxDynamicSharedMemorySize, LDS_BYTES) != hipSuccess) { fprintf(stderr, "kernel_launch: hipFuncSetAttribute failed\n"); grid = -1; return; }
        if (hipOccupancyMaxActiveBlocksPerMultiprocessor(&per_cu, (const void*)mk_fwd, NTHR, LDS_BYTES) != hipSuccess || per_cu < 1) { fprintf(stderr, "kernel_launch: occupancy query says %d\n", per_cu); per_cu = 1; }
        (void)hipGetLastError();
        grid = cus;
    }
    if (grid < 0) return;
    unsigned char* ws = (unsigned char*)d_ws;
    (void)hipMemsetAsync(ws + WS_CTL, 0, 32768, stream);
    Args a{};
    { const float** p = (const float**)&a.I; for (int i = 0; i < 20; ++i) p[i] = (const float*)d_in[i]; }
    a.out = (float*)d_out; a.ws = ws; a.ph_lo = 0; a.ph_hi = 18;
    hipLaunchKernelGGL(mk_fwd, dim3(grid), dim3(NTHR), LDS_BYTES, stream, a);
}
```

```cpp
#include <hip/hip_runtime.h>
#include <cstdio>
#include <cstdint>

typedef unsigned short bf16;
typedef unsigned v4u __attribute__((ext_vector_type(4)));
typedef float f32x4 __attribute__((ext_vector_type(4)));
#define LAS __attribute__((address_space(3)))

constexpr int D = 1024, NB = 4, T = 4096, M = NB * T;
constexpr int H = 4, DK = 64, DV = 128, KEY = 256, VAL = 512, RANK = 16, CCH = 512, CW = 31;
constexpr int INC = 2576, NIN = 2816;
constexpr int FF = 2816, NE = 8, NGU = 2 * FF;
constexpr float EPS = 1e-6f;
constexpr int CHUNK = 128, NCH = T / CHUNK;

constexpr size_t MiB = 1u << 20;
constexpr size_t WS_CTL = 0;
constexpr size_t WS_WMGU = 2 * MiB;
constexpr size_t WS_WMD = 46 * MiB;
constexpr size_t WS_XB8 = 68 * MiB;
constexpr size_t WS_WIN1 = 134 * MiB;
constexpr size_t WS_WOUT1 = 140 * MiB;
constexpr size_t WS_XB = 142 * MiB;
constexpr size_t WS_SSQ = 174 * MiB;
constexpr size_t WS_MISC = 175 * MiB;
constexpr size_t WS_WIN0 = 177 * MiB;
constexpr size_t WS_WOUT0 = 183 * MiB;
constexpr size_t WS_WDGU = 185 * MiB;
constexpr size_t WS_WDD = 196 * MiB;
constexpr size_t WS_TMP = 202 * MiB;
constexpr size_t WS_QS = WS_TMP, WS_KB = WS_TMP + 8 * MiB, WS_VB = WS_TMP + 16 * MiB, WS_SG = WS_TMP + 32 * MiB, WS_LA = WS_TMP + 48 * MiB, WS_UB = WS_TMP + 64 * MiB;
constexpr size_t WS_QT = WS_TMP + 80 * MiB, WS_OI = WS_TMP + 88 * MiB, WS_DS = WS_TMP + 104 * MiB, WS_SP = WS_TMP + 136 * MiB, WS_MIX = WS_TMP + 152 * MiB;
constexpr size_t WS_ACT = WS_TMP;
constexpr size_t WS_END = WS_TMP + 184 * MiB;
constexpr size_t MI_SEL = 0, MI_DEC = 768 * 1024;

__device__ __forceinline__ float bf2f(bf16 b) { return __uint_as_float(((unsigned)b) << 16); }
__device__ __forceinline__ unsigned f2bf(float f) { unsigned u = __float_as_uint(f); return (u + 0x7fffu + ((u >> 16) & 1u)) >> 16; }
__device__ __forceinline__ unsigned pk2(float lo, float hi) { return f2bf(lo) | (f2bf(hi) << 16); }
__device__ __forceinline__ float sigmoidf_(float x) { return 1.f / (1.f + __expf(-x)); }
__device__ __forceinline__ float siluf_(float x) { return x / (1.f + __expf(-x)); }
__device__ __forceinline__ float logsigf_(float x) { return fminf(x, 0.f) - log1pf(__expf(-fabsf(x))); }
__device__ __forceinline__ float wave_sum(float v) {
#pragma unroll
    for (int o = 1; o < 64; o <<= 1) v += __shfl_xor(v, o);
    return v;
}
__device__ __forceinline__ float row_rstd(const float* ssq, int row) {
    const f32x4* p = (const f32x4*)(ssq + (size_t)row * 16);
    f32x4 a = p[0], b = p[1], c = p[2], d = p[3];
    float s = ((a.x + a.y) + (a.z + a.w)) + ((b.x + b.y) + (b.z + b.w)) + ((c.x + c.y) + (c.z + c.w)) + ((d.x + d.y) + (d.z + d.w));
    return rsqrtf(s * (1.f / D) + EPS);
}

struct Inputs {
    const float *x, *ln1_w, *w_in, *w_gate_up, *b_gate, *gla_norm_w, *conv_w, *conv_b, *cn_w, *cn_b, *w_out, *ln2_w, *wd_gate, *wd_up, *wd_down, *w_router, *we_gate, *we_up, *we_down, *final_w;
};

constexpr float W8_MUL = 64.f;
struct CvtP { const float* W; const float* scale; void* WT; int ld, col0, K, row0, kb, nb, fp8; };
__device__ __forceinline__ void cvt_load(const CvtP& P, f32x4 (&v)[16], int lane) {
    const int k0 = 64 * P.kb, n0 = 64 * P.nb, n4 = 4 * (lane & 15), kq = lane >> 4;
#pragma unroll
    for (int i = 0; i < 16; ++i) v[i] = *(const f32x4*)(P.W + (size_t)(k0 + kq + 4 * i) * P.ld + P.col0 + n0 + n4);
}
__device__ __forceinline__ void cvt_finish(const CvtP& P, f32x4 (&v)[16], LAS float* scr, int lane) {
    const int k0 = 64 * P.kb, n0 = 64 * P.nb, n4 = 4 * (lane & 15), kq = lane >> 4; const float mul = P.fp8 ? W8_MUL : 1.f;
#pragma unroll
    for (int i = 0; i < 16; ++i) v[i] *= P.scale ? P.scale[k0 + kq + 4 * i] * mul : mul;
#pragma unroll
    for (int i = 0; i < 16; ++i) { const int k = kq + 4 * i; *(LAS f32x4*)(scr + k * 64 + (n4 ^ (4 * (k >> 3)))) = v[i]; }
    asm volatile("s_waitcnt lgkmcnt(0)" ::: "memory");
    if (P.fp8) { const int c = lane & 3; unsigned char* WT = (unsigned char*)P.WT;
#pragma unroll
        for (int j = 0; j < 4; ++j) { const int n = (lane >> 2) + 16 * j; unsigned w[4];
#pragma unroll
            for (int q = 0; q < 4; ++q) { float x[4];
#pragma unroll
                for (int r = 0; r < 4; ++r) { const int k = 16 * c + 4 * q + r; x[r] = scr[k * 64 + (n ^ (4 * (k >> 3)))]; }
                int t = 0; t = __builtin_amdgcn_cvt_pk_fp8_f32(x[0], x[1], t, false); t = __builtin_amdgcn_cvt_pk_fp8_f32(x[2], x[3], t, true); w[q] = (unsigned)t; }
            *(v4u*)(WT + (size_t)(P.row0 + n0 + n) * P.K + k0 + 16 * c) = (v4u){w[0], w[1], w[2], w[3]}; }
    } else { const int c = lane & 7; bf16* WT = (bf16*)P.WT;
#pragma unroll
        for (int j = 0; j < 8; ++j) { const int n = (lane >> 3) + 8 * j; const LAS float* sp = scr + (8 * c) * 64 + (n ^ (4 * c));
            v4u o; o.x = pk2(sp[0 * 64], sp[1 * 64]); o.y = pk2(sp[2 * 64], sp[3 * 64]); o.z = pk2(sp[4 * 64], sp[5 * 64]); o.w = pk2(sp[6 * 64], sp[7 * 64]);
            *(v4u*)(WT + (size_t)(P.row0 + n0 + n) * P.K + k0 + 8 * c) = o; }
    }
    asm volatile("s_waitcnt lgkmcnt(0)" ::: "memory");
}
constexpr int CVT_ITEMS = (20 + 20 + 8 + 8 + 44) * 32 + 8 * 88 + 8 * 44 * 32 + 8 * 8 * 88;
__device__ __forceinline__ CvtP cvt_decode(const Inputs& I, unsigned char* ws, int it) {
    CvtP P; int job, r = it; P.fp8 = 0; P.scale = nullptr; P.K = 1024;
    if (r < 40 * 32) { job = r / (20 * 32); r -= job * 20 * 32; const int seg = r / 32, q = r % 32;
        if (seg < 12) { P.col0 = 128 * seg; P.row0 = 128 * seg; } else { const int t = (seg - 12) >> 1, hf = (seg - 12) & 1; P.col0 = (hf ? 2064 : 1552) + 128 * t; P.row0 = 1792 + 256 * t + 128 * hf; }
        P.W = I.w_in + (size_t)job * D * INC; P.ld = INC; P.WT = ws + (job ? WS_WIN1 : WS_WIN0); P.scale = I.ln1_w + job * D; P.kb = q >> 1; P.nb = q & 1; return P; }
    r -= 40 * 32;
    if (r < 16 * 32) { job = r / (8 * 32); r -= job * 8 * 32; const int seg = r / 32, q = r % 32;
        P.W = I.w_out + (size_t)job * D * D; P.ld = D; P.col0 = 128 * seg; P.row0 = 128 * seg; P.WT = ws + (job ? WS_WOUT1 : WS_WOUT0); P.kb = q >> 1; P.nb = q & 1; return P; }
    r -= 16 * 32;
    if (r < 44 * 32) { const int seg = r / 32, q = r % 32, t = seg >> 1, hf = seg & 1;
        P.W = hf ? I.wd_up : I.wd_gate; P.ld = FF; P.col0 = 128 * t; P.row0 = 256 * t + 128 * hf; P.WT = ws + WS_WDGU; P.scale = I.ln2_w; P.kb = q >> 1; P.nb = q & 1; return P; }
    r -= 44 * 32;
    if (r < 8 * 88) { const int seg = r / 88, q = r % 88;
        P.W = I.wd_down; P.ld = D; P.col0 = 128 * seg; P.row0 = 128 * seg; P.K = FF; P.WT = ws + WS_WDD; P.kb = q >> 1; P.nb = q & 1; return P; }
    r -= 8 * 88;
    if (r < 8 * 44 * 32) { const int e = r / (44 * 32); r -= e * 44 * 32; const int seg = r / 32, q = r % 32, t = seg >> 1, hf = seg & 1;
        P.W = (hf ? I.we_up : I.we_gate) + (size_t)e * D * FF; P.ld = FF; P.col0 = 128 * t; P.row0 = 256 * t + 128 * hf; P.WT = ws + WS_WMGU + (size_t)e * NGU * D; P.scale = I.ln2_w + D; P.fp8 = 1; P.kb = q >> 1; P.nb = q & 1; return P; }
    r -= 8 * 44 * 32;
    { const int e = r / (8 * 88); r -= e * 8 * 88; const int seg = r / 88, q = r % 88;
        P.W = I.we_down + (size_t)e * FF * D; P.ld = D; P.col0 = 128 * seg; P.row0 = 128 * seg; P.K = FF; P.WT = ws + WS_WMD + (size_t)e * D * FF; P.fp8 = 1; P.kb = q >> 1; P.nb = q & 1; return P; }
}
__device__ __forceinline__ void cvt_all(const Inputs& I, unsigned char* ws, int gw, int NGW, LAS float* scr, int lane) {
    int it = gw; if (it >= CVT_ITEMS) return;
    CvtP P = cvt_decode(I, ws, it); f32x4 v[16]; cvt_load(P, v, lane);
    for (;;) { const int itn = it + NGW; const bool more = itn < CVT_ITEMS;
        CvtP Pn = P; f32x4 vn[16];
        if (more) { Pn = cvt_decode(I, ws, itn); cvt_load(Pn, vn, lane); }
        cvt_finish(P, v, scr, lane);
        if (!more) break;
        P = Pn; it = itn;
#pragma unroll
        for (int i = 0; i < 16; ++i) v[i] = vn[i];
    }
}
__device__ __forceinline__ void cvt_gate_elem(const Inputs& I, unsigned char* ws, int idx) {
    const int l = idx >> 18, j = (idx >> 10) & 255, k = idx & 1023;
    const float* wr = I.w_in + (size_t)l * D * INC + (size_t)k * INC + 1536; const float* gu = I.w_gate_up + l * RANK * KEY + j;
    float s = 0.f;
#pragma unroll
    for (int r = 0; r < RANK; ++r) s += wr[r] * gu[r * KEY];
    bf16* dst = (bf16*)(ws + (l ? WS_WIN1 : WS_WIN0));
    dst[(size_t)(1536 + j) * D + k] = (bf16)f2bf(s * I.ln1_w[l * D + k]);
}
__device__ __forceinline__ void row_to_xb(const float* xrow, bf16* orow, float* ssqrow, int lane) {
    const f32x4* xr = (const f32x4*)xrow + lane; f32x4 v[4]; float s = 0.f;
#pragma unroll
    for (int j = 0; j < 4; ++j) { v[j] = xr[64 * j]; s += (v[j].x * v[j].x + v[j].y * v[j].y) + (v[j].z * v[j].z + v[j].w * v[j].w); }
    s = wave_sum(s);
    unsigned long long* o8 = (unsigned long long*)orow + lane;
#pragma unroll
    for (int j = 0; j < 4; ++j) o8[64 * j] = (unsigned long long)pk2(v[j].x, v[j].y) | ((unsigned long long)pk2(v[j].z, v[j].w) << 32);
    if (lane < 16) ssqrow[lane] = lane == 0 ? s : 0.f;
}

__device__ __forceinline__ int opaque_tid() { int t = threadIdx.x; asm volatile("" : "+v"(t)); return t; }
namespace pg8 {
#define PG8_LAS __attribute__((address_space(3)))
typedef short bf16x8 __attribute__((ext_vector_type(8)));
typedef unsigned u32x4 __attribute__((ext_vector_type(4)));
constexpr int BM = 256, BK = 64, HALF = 128, HTB = HALF * BK * 2  , STAGE_BYTES = 8 * HTB, NXCD = 8, WGM = 8;

__host__ __device__ __forceinline__ int lds_byte(int r, int c) { return r * 128 + ((((c >> 3) ^ ((r >> 1) & 7)) << 4)) + (c & 7) * 2; }
__host__ __device__ __forceinline__ void stage_rc(int b, int& R, int& C) { R = b >> 7; C = (((b >> 4) & 7) ^ ((R >> 1) & 7)) * 8; }
__host__ __device__ __forceinline__ int perm32(int rho) { const int n = rho >> 4, i = rho & 15; return 8 * (i >> 2) + 4 * n + (i & 3); }

struct Unit { int pm, pn, e, hm; };

__device__ __forceinline__ void unit_of(int wgid, int nM, int NN, int q, int r, int& pm, int& pn) {
    { const int xcd = wgid & (NXCD - 1), off = wgid >> 3; wgid = (xcd < r ? xcd * (q + 1) : r * (q + 1) + (xcd - r) * q) + off; }
    const int nig = WGM * NN, gid = wgid / nig, fm = gid * WGM, gsz = (nM - fm) < WGM ? (nM - fm) : WGM, rem = wgid - gid * nig;
    if (gsz == WGM) { pm = fm + (rem & (WGM - 1)); pn = rem >> 3; } else { pm = fm + rem % gsz; pn = rem / gsz; }
}
template <int NN, bool SPLIT = false> struct StaticOrder {
    static constexpr bool GATHER = false;
    int nM, nwg, G, c, q, r, nfull; const bf16* Bt;
    __device__ void init(int nM_, int G_, int c_, const bf16* Bt_) { nM = nM_; nwg = nM * NN; G = G_; c = c_; Bt = Bt_; q = nwg >> 3; r = nwg & 7; nfull = (SPLIT && 2 * (nwg % G) <= G) ? (nwg / G) * G : nwg; }
    __device__ __forceinline__ bool next(int i, Unit& u) const { int L = i * G + c; u.hm = -1; u.e = 0;
        if (L >= nfull) { const int j = L - nfull; if (j >= 2 * (nwg - nfull)) return false; L = nfull + (j >> 1); u.hm = j & 1; }
        unit_of(L, nM, NN, q, r, u.pm, u.pn); return true; }
    __device__ __forceinline__ const void* bt_root() const { return Bt; }
    __device__ __forceinline__ int bt_off(const Unit&) const { return 0; }
    __device__ __forceinline__ int row_src(const Unit&, int) const { return 0; }
};
template <bool GATHER_, int NN, bool SPLIT = false> struct MoeOrder {
    static constexpr bool GATHER = GATHER_;
    int nM, nwg, G, c, q, r, nfull; const char* Bt; size_t estride; const PG8_LAS int* tile_e; const int* rowinfo;
    __device__ void init(int nM_, int G_, int c_, const void* Bt_, size_t estride_, const PG8_LAS int* tile_e_, const int* rowinfo_) { nM = nM_; nwg = nM * NN; G = G_; c = c_; Bt = (const char*)Bt_; estride = estride_; tile_e = tile_e_; rowinfo = rowinfo_; q = nwg >> 3; r = nwg & 7;
        nfull = (SPLIT && 2 * (nwg % G) <= G) ? (nwg / G) * G : nwg; }
    __device__ __forceinline__ bool next(int i, Unit& u) const { int L = i * G + c; u.hm = -1;
        if (L >= nfull) { const int j = L - nfull; if (j >= 2 * (nwg - nfull)) return false; L = nfull + (j >> 1); u.hm = j & 1; }
        unit_of(L, nM, NN, q, r, u.pm, u.pn); u.e = __builtin_amdgcn_readfirstlane(tile_e[u.pm]); return true; }
    __device__ __forceinline__ const void* bt_root() const { return Bt; }
    __device__ __forceinline__ int bt_off(const Unit& u) const { return u.e * (int)estride; }
    __device__ __forceinline__ int row_src(const Unit& u, int R) const { return __hip_atomic_load(rowinfo + u.pm * BM + (u.hm > 0 ? HALF : 0) + R, __ATOMIC_RELAXED, __HIP_MEMORY_SCOPE_AGENT) & 0x3fff; }
};

typedef int v4i_ __attribute__((ext_vector_type(4)));
typedef int v8i_ __attribute__((ext_vector_type(8)));
__device__ __forceinline__ v8i_ cat8(const bf16x8 a, const bf16x8 b) { const v4i_ x = __builtin_bit_cast(v4i_, a), y = __builtin_bit_cast(v4i_, b); return __builtin_shufflevector(x, y, 0, 1, 2, 3, 4, 5, 6, 7); }
__device__ __forceinline__ unsigned cvt_pk_bf16(float lo, float hi) { unsigned r; asm volatile("v_cvt_pk_bf16_f32 %0, %1, %2" : "=v"(r) : "v"(lo), "v"(hi)); return r; }
__device__ __forceinline__ u32x4 pack8(const f32x4 a, const f32x4 b) { u32x4 w; w.x = cvt_pk_bf16(a[0], a[1]); w.y = cvt_pk_bf16(a[2], a[3]); w.z = cvt_pk_bf16(b[0], b[1]); w.w = cvt_pk_bf16(b[2], b[3]); return w; }

template <class Epi, class Sched, bool ALIGN_EPI = false, bool SP2 = false, bool FP8 = false, int SCALE_W = 0x7f7f7f7f, int SCALE_X = 0x7f7f7f7f>
__device__ __forceinline__ void gemm_phase(PG8_LAS unsigned char* lds, PG8_LAS float* tab, const void* Abase, const int K, const Sched& S, const Epi& E) {
    const int tid = opaque_tid(), wid = __builtin_amdgcn_readfirstlane(tid >> 6), lane = tid & 63, wr = wid >> 2, wc = wid & 3, fr = lane & 15, fq = lane >> 4;
    const int rowb = FP8 ? K : 2 * K;
    const int nt = rowb / 128;
    Unit cur, nxt; int ui = 0;
    if (!S.next(0, cur)) return;
    bool has_next = S.next(1, nxt);
    E.prep_store(E.prep_load(cur, tid), tab, 0, tid); __builtin_amdgcn_sched_barrier(0);
    const int kstep = BK * 2;
    const int hstep = HALF * rowb;
    const int tstep = 2 * hstep;
    unsigned voffB[2], vA[2][2], vN[2][2];
#pragma unroll
    for (int i = 0; i < 2; ++i) { int R, C; stage_rc(tid * 16 + i * 8192, R, C); const int Rb = Epi::PERM ? ((R & ~31) + perm32(R & 31)) : R;
        voffB[i] = (unsigned)(Rb * rowb + C * 2);
#pragma unroll
        for (int h = 0; h < 2; ++h) { vA[h][i] = (unsigned)(R * rowb + C * 2); vN[h][i] = vA[h][i]; } }
    const int hA = Sched::GATHER ? 0 : hstep;
    const unsigned ldsw = (unsigned)wid * 1024u;
    const int aoff0 = lds_byte(wr * 64 + fr, fq * 8), aoff1 = lds_byte(wr * 64 + fr, 32 + fq * 8), boff0 = lds_byte(wc * 32 + fr, fq * 8), boff1 = lds_byte(wc * 32 + fr, 32 + fq * 8);
#define PG8_SA(b, h) (((b) * 2 + (h)) * HTB)
#define PG8_SB(b, h) ((4 + (b) * 2 + (h)) * HTB)
#define PG8_STAGE(bufoff, rsrc, soff, voff) do { _Pragma("unroll") for (int _i = 0; _i < 2; ++_i) \
        __builtin_amdgcn_raw_ptr_buffer_load_lds(rsrc, (PG8_LAS void*)(lds + (bufoff) + ldsw + _i * 8192), 16, (int)(voff)[_i], (int)(soff), 0, 0); } while (0)
#define PG8_LD8(p0, p1) __builtin_shufflevector(*(const PG8_LAS v4i_*)(p0), *(const PG8_LAS v4i_*)(p1), 0, 1, 2, 3, 4, 5, 6, 7)
#define PG8_LDA(dst, b, h) do { if constexpr (FP8) { _Pragma("unroll") for (int m = 0; m < 4; ++m) dst##8[m] = PG8_LD8(lds + PG8_SA(b, h) + aoff0 + m * 2048, lds + PG8_SA(b, h) + aoff1 + m * 2048); } else { \
        _Pragma("unroll") for (int m = 0; m < 4; ++m) { dst[m][0] = *(const PG8_LAS bf16x8*)(lds + PG8_SA(b, h) + aoff0 + m * 2048); dst[m][1] = *(const PG8_LAS bf16x8*)(lds + PG8_SA(b, h) + aoff1 + m * 2048); } } } while (0)
#define PG8_LDB(dst, b, h) do { if constexpr (FP8) { _Pragma("unroll") for (int n = 0; n < 2; ++n) dst##8[n] = PG8_LD8(lds + PG8_SB(b, h) + boff0 + n * 2048, lds + PG8_SB(b, h) + boff1 + n * 2048); } else { \
        _Pragma("unroll") for (int n = 0; n < 2; ++n) { dst[n][0] = *(const PG8_LAS bf16x8*)(lds + PG8_SB(b, h) + boff0 + n * 2048); dst[n][1] = *(const PG8_LAS bf16x8*)(lds + PG8_SB(b, h) + boff1 + n * 2048); } } } while (0)
#define PG8_MMA(ai, bj, At, Bt) do { __builtin_amdgcn_s_setprio(1); if constexpr (FP8) { _Pragma("unroll") for (int m = 0; m < 4; ++m) _Pragma("unroll") for (int n = 0; n < 2; ++n) \
        asm volatile("v_mfma_scale_f32_16x16x128_f8f6f4 %0, %1, %2, %0, %3, %4 op_sel_hi:[0,0,0]" : "+v"(acc[ai][bj][m][n]) : "v"(Bt##8[n]), "v"(At##8[m]), "v"(scw), "v"(scx)); } else { \
        _Pragma("unroll") for (int m = 0; m < 4; ++m) _Pragma("unroll") for (int n = 0; n < 2; ++n) _Pragma("unroll") for (int k = 0; k < 2; ++k) \
        acc[ai][bj][m][n] = __builtin_amdgcn_mfma_f32_16x16x32_bf16(Bt[n][k], At[m][k], acc[ai][bj][m][n], 0, 0, 0); } __builtin_amdgcn_s_setprio(0); } while (0)
#define PG8_WAIT_V(n) asm volatile("s_waitcnt vmcnt(" #n ")" ::: "memory")
#define PG8_WAIT_L(n) asm volatile("s_waitcnt lgkmcnt(" #n ")" ::: "memory")
#define PG8_BAR __builtin_amdgcn_s_barrier()
#define PG8_SCHED __builtin_amdgcn_sched_barrier(0)
    f32x4 acc[2][2][4][2];
#pragma unroll
    for (int a = 0; a < 2; ++a)
#pragma unroll
        for (int b = 0; b < 2; ++b)
#pragma unroll
            for (int m = 0; m < 4; ++m)
#pragma unroll
                for (int n = 0; n < 2; ++n) acc[a][b][m][n] = (f32x4){0.f, 0.f, 0.f, 0.f};
    int scw = SCALE_W, scx = SCALE_X; asm volatile("" : "+v"(scw), "+v"(scx));
    bf16x8 At[4][2], B0[2][2], B1[2][2]; v8i_ At8[4], B08[2], B18[2];
    const __amdgpu_buffer_rsrc_t rA = __builtin_amdgcn_make_buffer_rsrc((void*)Abase, 0, 0xffffffff, 0x00020000), rB = __builtin_amdgcn_make_buffer_rsrc((void*)S.bt_root(), 0, 0xffffffff, 0x00020000);
    int cA, cB = S.bt_off(cur) + cur.pn * tstep;
    if constexpr (Sched::GATHER) {
        cA = 0;
#pragma unroll
        for (int h = 0; h < 2; ++h)
#pragma unroll
            for (int i = 0; i < 2; ++i) { int R, C; stage_rc(tid * 16 + i * 8192, R, C); vA[h][i] = (unsigned)(S.row_src(cur, h * HALF + R) * rowb + C * 2); vN[h][i] = has_next ? (unsigned)(S.row_src(nxt, h * HALF + R) * rowb + C * 2) : vA[h][i]; }
    } else cA = cur.pm * tstep + (cur.hm > 0 ? hstep : 0);
    asm volatile("" : "+v"(voffB[0]), "+v"(voffB[1]), "+v"(vA[0][0]), "+v"(vA[0][1]), "+v"(vA[1][0]), "+v"(vA[1][1]));
    if constexpr (SP2) {
        PG8_STAGE(PG8_SB(0, 0), rB, cB, voffB); PG8_STAGE(PG8_SB(0, 1), rB, cB + hstep, voffB); PG8_STAGE(PG8_SA(0, 0), rA, cA, vA[0]); PG8_STAGE(PG8_SA(0, 1), rA, cA + hA, vA[1]);
        if (wr == 1) PG8_BAR;
        PG8_WAIT_V(2); PG8_BAR;
        PG8_STAGE(PG8_SB(1, 0), rB, cB + kstep, voffB); PG8_STAGE(PG8_SA(1, 0), rA, cA + kstep, vA[0]); PG8_STAGE(PG8_SB(1, 1), rB, cB + hstep + kstep, voffB);
        PG8_WAIT_V(6); PG8_BAR;
    } else {
        PG8_STAGE(PG8_SB(0, 0), rB, cB, voffB); PG8_STAGE(PG8_SA(0, 0), rA, cA, vA[0]); PG8_STAGE(PG8_SB(0, 1), rB, cB + hstep, voffB); PG8_STAGE(PG8_SA(0, 1), rA, cA + hA, vA[1]);
        if (wr == 1) PG8_BAR;
        PG8_WAIT_V(4); PG8_BAR;
        PG8_STAGE(PG8_SB(1, 0), rB, cB + kstep, voffB); PG8_STAGE(PG8_SA(1, 0), rA, cA + kstep, vA[0]); PG8_STAGE(PG8_SB(1, 1), rB, cB + hstep + kstep, voffB);
        PG8_WAIT_V(6); PG8_BAR;
    }
    for (;;) {
        int nA; const int nB = has_next ? S.bt_off(nxt) + nxt.pn * tstep : cB;
        if constexpr (Sched::GATHER) nA = cA; else nA = has_next ? nxt.pm * tstep + (nxt.hm > 0 ? hstep : 0) : cA;
        const bool whole = cur.hm < 0;
#pragma clang loop unroll(disable)
        for (int t = 0; t < nt; t += 2) {
            const bool last = (t == nt - 2);
            const int a1 = cA + (t + 1) * kstep;
            const int a2 = last ? nA : cA + (t + 2) * kstep; const int b2 = last ? nB : cB + (t + 2) * kstep;
            const int a3 = a2 + kstep; const int b3 = b2 + kstep;
            unsigned v2[2][2];
#pragma unroll
            for (int h = 0; h < 2; ++h)
#pragma unroll
                for (int i = 0; i < 2; ++i) v2[h][i] = (Sched::GATHER && last) ? vN[h][i] : vA[h][i];
            if constexpr (SP2) {
            PG8_LDB(B0, 0, 0); PG8_LDB(B1, 0, 1); PG8_SCHED; PG8_LDA(At, 0, 0); PG8_STAGE(PG8_SA(1, 1), rA, a1 + hA, vA[1]);
            PG8_WAIT_V(8); PG8_WAIT_L(0); PG8_BAR; PG8_MMA(0, 0, At, B0); PG8_MMA(0, 1, At, B1); PG8_BAR; PG8_SCHED;
            PG8_LDA(At, 0, 1); PG8_STAGE(PG8_SB(0, 0), rB, b2, voffB); PG8_STAGE(PG8_SB(0, 1), rB, b2 + hstep, voffB); PG8_STAGE(PG8_SA(0, 0), rA, a2, v2[0]);
            PG8_WAIT_V(8); PG8_WAIT_L(0); PG8_BAR; if (whole) { PG8_MMA(1, 0, At, B0); PG8_MMA(1, 1, At, B1); } PG8_BAR; PG8_SCHED;
            PG8_LDB(B0, 1, 0); PG8_LDB(B1, 1, 1); PG8_SCHED; PG8_LDA(At, 1, 0); PG8_STAGE(PG8_SA(0, 1), rA, a2 + hA, v2[1]);
            PG8_WAIT_V(8); PG8_WAIT_L(0); PG8_BAR; PG8_MMA(0, 0, At, B0); PG8_MMA(0, 1, At, B1); PG8_BAR; PG8_SCHED;
            PG8_LDA(At, 1, 1); PG8_STAGE(PG8_SB(1, 0), rB, b3, voffB); PG8_STAGE(PG8_SB(1, 1), rB, b3 + hstep, voffB); PG8_STAGE(PG8_SA(1, 0), rA, a3, v2[0]);
            PG8_WAIT_V(8); PG8_WAIT_L(0); PG8_BAR; if (whole) { PG8_MMA(1, 0, At, B0); PG8_MMA(1, 1, At, B1); } PG8_BAR; PG8_SCHED;
            } else {
            PG8_LDB(B0, 0, 0); PG8_SCHED; PG8_LDA(At, 0, 0); PG8_STAGE(PG8_SA(1, 1), rA, a1 + hA, vA[1]);
            PG8_WAIT_L(8); PG8_BAR; PG8_WAIT_L(0); PG8_MMA(0, 0, At, B0); PG8_BAR; PG8_SCHED;
            PG8_LDB(B1, 0, 1); PG8_STAGE(PG8_SB(0, 0), rB, b2, voffB);
            PG8_BAR; PG8_WAIT_L(0); PG8_MMA(0, 1, At, B1); PG8_BAR;
            PG8_LDA(At, 0, 1); PG8_STAGE(PG8_SA(0, 0), rA, a2, v2[0]);
            PG8_BAR; PG8_WAIT_L(0); PG8_MMA(1, 0, At, B0); PG8_BAR; PG8_SCHED;
            PG8_STAGE(PG8_SB(0, 1), rB, b2 + hstep, voffB);
            PG8_WAIT_V(6); PG8_BAR; PG8_MMA(1, 1, At, B1); PG8_BAR;
            PG8_LDB(B0, 1, 0); PG8_SCHED; PG8_LDA(At, 1, 0); PG8_STAGE(PG8_SA(0, 1), rA, a2 + hA, v2[1]);
            PG8_WAIT_L(8); PG8_BAR; PG8_WAIT_L(0); PG8_MMA(0, 0, At, B0); PG8_BAR; PG8_SCHED;
            PG8_LDB(B1, 1, 1); PG8_STAGE(PG8_SB(1, 0), rB, b3, voffB);
            PG8_BAR; PG8_WAIT_L(0); PG8_MMA(0, 1, At, B1); PG8_BAR;
            PG8_LDA(At, 1, 1); PG8_STAGE(PG8_SA(1, 0), rA, a3, v2[0]);
            PG8_BAR; PG8_WAIT_L(0); PG8_MMA(1, 0, At, B0); PG8_BAR; PG8_SCHED;
            PG8_STAGE(PG8_SB(1, 1), rB, b3 + hstep, voffB);
            PG8_WAIT_V(6); PG8_BAR; PG8_MMA(1, 1, At, B1); PG8_BAR;
            }
        }
        if constexpr (ALIGN_EPI) { if (wr == 0) PG8_BAR; }
        if constexpr (FP8) asm volatile("s_nop 15\n\ts_nop 15" ::: "memory");
        const int tid2 = opaque_tid(), lane2 = tid2 & 63;
        typename Epi::Prep pr; if (has_next) pr = E.prep_load(nxt, tid2);
        E(acc, cur, tab + (ui & 1) * 512, wr, wc, lane2 & 15, lane2 >> 4);
        if (!has_next) break;
        E.prep_store(pr, tab, (ui + 1) & 1, tid2); __builtin_amdgcn_sched_barrier(0);
#pragma unroll
        for (int a = 0; a < 2; ++a)
#pragma unroll
            for (int b = 0; b < 2; ++b)
#pragma unroll
                for (int m = 0; m < 4; ++m)
#pragma unroll
                    for (int n = 0; n < 2; ++n) acc[a][b][m][n] = (f32x4){0.f, 0.f, 0.f, 0.f};
        Unit nn; const bool has2 = S.next(ui + 2, nn);
        if constexpr (Sched::GATHER) {
#pragma unroll
            for (int h = 0; h < 2; ++h)
#pragma unroll
                for (int i = 0; i < 2; ++i) { int R, C; stage_rc(tid2 * 16 + i * 8192, R, C); const unsigned tnew = has2 ? (unsigned)(S.row_src(nn, h * HALF + R) * rowb + C * 2) : vN[h][i]; vA[h][i] = vN[h][i]; vN[h][i] = tnew; }
        }
        cur = nxt; nxt = nn; has_next = has2; cA = nA; cB = nB; ++ui;
        if constexpr (ALIGN_EPI) { if (wr == 1) PG8_BAR; }
    }
    PG8_WAIT_V(0);
    if constexpr (!ALIGN_EPI) { if (wr == 0) PG8_BAR; }
    PG8_BAR;
#undef PG8_SA
#undef PG8_SB
#undef PG8_STAGE
#undef PG8_LDA
#undef PG8_LDB
#undef PG8_MMA
#undef PG8_WAIT_V
#undef PG8_WAIT_L
#undef PG8_BAR
#undef PG8_SCHED
}
}
namespace pg8 {
__device__ __forceinline__ float silu_fast(float x) { return x * __builtin_amdgcn_rcpf(1.f + __expf(-x)); }
__device__ __forceinline__ float sigm_fast(float x) { return __builtin_amdgcn_rcpf(1.f + __expf(-x)); }
__device__ __forceinline__ f32x4 silu4(const f32x4 v) { f32x4 o; o[0] = silu_fast(v[0]); o[1] = silu_fast(v[1]); o[2] = silu_fast(v[2]); o[3] = silu_fast(v[3]); return o; }
__device__ __forceinline__ f32x4 sigm4(const f32x4 v) { f32x4 o; o[0] = sigm_fast(v[0]); o[1] = sigm_fast(v[1]); o[2] = sigm_fast(v[2]); o[3] = sigm_fast(v[3]); return o; }
__device__ __forceinline__ unsigned long long pack8_fp8(const f32x4 a, const f32x4 b) { int lo = 0, hi = 0; lo = __builtin_amdgcn_cvt_pk_fp8_f32(a[0], a[1], lo, false); lo = __builtin_amdgcn_cvt_pk_fp8_f32(a[2], a[3], lo, true);
    hi = __builtin_amdgcn_cvt_pk_fp8_f32(b[0], b[1], hi, false); hi = __builtin_amdgcn_cvt_pk_fp8_f32(b[2], b[3], hi, true); return (unsigned long long)(unsigned)lo | ((unsigned long long)(unsigned)hi << 32); }
__device__ __forceinline__ float logsig_fast(float x) { return fminf(x, 0.f) - __logf(1.f + __expf(-fabsf(x))); }
struct PrepNone { };
struct Prep2 { float a, b; };
struct EpiIn {
    static constexpr bool PERM = true; typedef Prep2 Prep;
    const float* ssq; const float* b_gate; bf16 *QS, *KB, *VB, *SG, *UB; float* LA;
    __device__ __forceinline__ Prep prep_load(const Unit& u, int tid) const { Prep p; p.b = 0.f; p.a = row_rstd(ssq, u.pm * BM + (u.hm > 0 ? HALF : 0) + (tid & 255)); return p; }
    __device__ __forceinline__ void prep_store(const Prep& p, PG8_LAS float* tab, int par, int tid) const { tab[par * 512 + (tid & 255)] = p.a; }
    __device__ __forceinline__ void operator()(const f32x4 (&acc)[2][2][4][2], const Unit& u, const PG8_LAS float* tb, int wr, int wc, int fr, int fq) const {
        const int tile = u.pn, cin = wc * 32 + 8 * fq, rb0 = u.pm * BM + (u.hm > 0 ? HALF : 0);
        f32x4 bg[2][2];
        if (tile == 6) {
#pragma unroll
            for (int bj = 0; bj < 2; ++bj)
#pragma unroll
                for (int n = 0; n < 2; ++n) bg[bj][n] = *(const f32x4*)(b_gate + bj * 128 + cin + 4 * n);
        }
#pragma unroll
        for (int ai = 0; ai < 2; ++ai) if (ai == 0 || u.hm < 0)
#pragma unroll
            for (int m = 0; m < 4; ++m) {
                const int lr = ai * HALF + wr * 64 + m * 16 + fr, row = rb0 + lr; const float r = tb[lr];
                const f32x4 l0 = acc[ai][0][m][0] * r, l1 = acc[ai][0][m][1] * r, h0 = acc[ai][1][m][0] * r, h1 = acc[ai][1][m][1] * r;
                if (tile == 0) { bf16* p = QS + (size_t)row * KEY + cin; *(u32x4*)p = pack8(l0 * 0.125f, l1 * 0.125f); *(u32x4*)(p + 128) = pack8(h0 * 0.125f, h1 * 0.125f); }
                else if (tile == 1) { bf16* p = KB + (size_t)row * KEY + cin; *(u32x4*)p = pack8(l0, l1); *(u32x4*)(p + 128) = pack8(h0, h1); }
                else if (tile < 4) { bf16* p = VB + (size_t)row * VAL + (tile - 2) * 256 + cin; *(u32x4*)p = pack8(l0, l1); *(u32x4*)(p + 128) = pack8(h0, h1); }
                else if (tile < 6) { bf16* p = SG + (size_t)row * VAL + (tile - 4) * 256 + cin; *(u32x4*)p = pack8(silu4(l0), silu4(l1)); *(u32x4*)(p + 128) = pack8(silu4(h0), silu4(h1)); }
                else if (tile == 6) { float* p = LA + (size_t)row * KEY + cin; f32x4 o;
#pragma unroll
                    for (int j = 0; j < 4; ++j) o[j] = logsig_fast(l0[j] + bg[0][0][j]) * 0.0625f; *(f32x4*)p = o;
#pragma unroll
                    for (int j = 0; j < 4; ++j) o[j] = logsig_fast(l1[j] + bg[0][1][j]) * 0.0625f; *(f32x4*)(p + 4) = o;
#pragma unroll
                    for (int j = 0; j < 4; ++j) o[j] = logsig_fast(h0[j] + bg[1][0][j]) * 0.0625f; *(f32x4*)(p + 128) = o;
#pragma unroll
                    for (int j = 0; j < 4; ++j) o[j] = logsig_fast(h1[j] + bg[1][1][j]) * 0.0625f; *(f32x4*)(p + 132) = o; }
                else { bf16* p = UB + (size_t)row * CCH + (tile - 7) * 128 + cin; *(u32x4*)p = pack8(l0 * sigm4(h0), l1 * sigm4(h1)); }
            }
    }
};
struct EpiRes {
    static constexpr bool PERM = true; typedef PrepNone Prep;
    bf16* XB; float* SSQ; unsigned char* X8;
    __device__ __forceinline__ Prep prep_load(const Unit&, int) const { return Prep(); }
    __device__ __forceinline__ void prep_store(const Prep&, PG8_LAS float*, int, int) const {}
    __device__ __forceinline__ void operator()(const f32x4 (&acc)[2][2][4][2], const Unit& u, const PG8_LAS float*, int wr, int wc, int fr, int fq) const {
        const int cin = wc * 32 + 8 * fq, rb0 = u.pm * BM + (u.hm > 0 ? HALF : 0); (void)rb0;
#pragma unroll
        for (int ai = 0; ai < 2; ++ai) if (ai == 0 || u.hm < 0) {
            u32x4 rv[4][2];
#pragma unroll
            for (int m = 0; m < 4; ++m) { const size_t o = (size_t)(rb0 + ai * HALF + wr * 64 + m * 16 + fr) * D + u.pn * BM + cin;
#pragma unroll
                for (int bj = 0; bj < 2; ++bj) rv[m][bj] = *(const u32x4*)(XB + o + bj * HALF); }
#pragma unroll
            for (int m = 0; m < 4; ++m) {
                const int row = rb0 + ai * HALF + wr * 64 + m * 16 + fr; const size_t o = (size_t)row * D + u.pn * BM + cin; float ss = 0.f;
#pragma unroll
                for (int bj = 0; bj < 2; ++bj) { const u32x4 r = rv[m][bj];
                    const f32x4 x0 = (f32x4){__uint_as_float(r.x << 16), __uint_as_float(r.x & 0xffff0000u), __uint_as_float(r.y << 16), __uint_as_float(r.y & 0xffff0000u)} + acc[ai][bj][m][0];
                    const f32x4 x1 = (f32x4){__uint_as_float(r.z << 16), __uint_as_float(r.z & 0xffff0000u), __uint_as_float(r.w << 16), __uint_as_float(r.w & 0xffff0000u)} + acc[ai][bj][m][1];
                    *(u32x4*)(XB + o + bj * HALF) = pack8(x0, x1);
                    if (X8) *(unsigned long long*)(X8 + o + bj * HALF) = pack8_fp8(x0, x1);
                    ss += (x0[0] * x0[0] + x0[1] * x0[1]) + (x0[2] * x0[2] + x0[3] * x0[3]) + (x1[0] * x1[0] + x1[1] * x1[1]) + (x1[2] * x1[2] + x1[3] * x1[3]); }
                ss += __shfl_xor(ss, 16); ss += __shfl_xor(ss, 32);
                if (fq == 0) SSQ[(size_t)row * 16 + u.pn * 4 + wc] = ss;
            }
            asm volatile("" ::: "memory");
        }
    }
};
struct EpiUp {
    static constexpr bool PERM = true; typedef Prep2 Prep;
    const float* ssq; bf16* ACT;
    __device__ __forceinline__ Prep prep_load(const Unit& u, int tid) const { Prep p; p.b = 0.f; p.a = row_rstd(ssq, u.pm * BM + (u.hm > 0 ? HALF : 0) + (tid & 255)); return p; }
    __device__ __forceinline__ void prep_store(const Prep& p, PG8_LAS float* tab, int par, int tid) const { tab[par * 512 + (tid & 255)] = p.a; }
    __device__ __forceinline__ void operator()(const f32x4 (&acc)[2][2][4][2], const Unit& u, const PG8_LAS float* tb, int wr, int wc, int fr, int fq) const {
        const int cin = wc * 32 + 8 * fq, rb0 = u.pm * BM + (u.hm > 0 ? HALF : 0); (void)rb0;
#pragma unroll
        for (int ai = 0; ai < 2; ++ai) if (ai == 0 || u.hm < 0)
#pragma unroll
            for (int m = 0; m < 4; ++m) {
                const int lr = ai * HALF + wr * 64 + m * 16 + fr, row = rb0 + lr; const float r = tb[lr];
                const f32x4 g0 = silu4(acc[ai][0][m][0] * r), g1 = silu4(acc[ai][0][m][1] * r);
                *(u32x4*)(ACT + (size_t)row * FF + u.pn * 128 + cin) = pack8(g0 * (acc[ai][1][m][0] * r), g1 * (acc[ai][1][m][1] * r));
            }
    }
};
struct EpiUpMoe {
    static constexpr bool PERM = true; typedef Prep2 Prep;
    const float* ssq; const int* rowinfo; const float* rowg; unsigned char* ACT;
    __device__ __forceinline__ Prep prep_load(const Unit& u, int tid) const { Prep p; p.a = 0.f; p.b = 0.f;
        { const int row = u.pm * BM + (u.hm > 0 ? HALF : 0) + (tid & 255); const int tok = rowinfo[row] & 0x3fff; p.a = row_rstd(ssq, tok); p.b = rowg[row] * p.a * 16.f; } return p; }
    __device__ __forceinline__ void prep_store(const Prep& p, PG8_LAS float* tab, int par, int tid) const { tab[par * 512 + (tid & 255)] = p.a; tab[par * 512 + 256 + (tid & 255)] = p.b; }
    __device__ __forceinline__ void operator()(const f32x4 (&acc)[2][2][4][2], const Unit& u, const PG8_LAS float* tb, int wr, int wc, int fr, int fq) const {
        const int cin = wc * 32 + 8 * fq, rb0 = u.pm * BM + (u.hm > 0 ? HALF : 0); (void)rb0;
#pragma unroll
        for (int ai = 0; ai < 2; ++ai) if (ai == 0 || u.hm < 0)
#pragma unroll
            for (int m = 0; m < 4; ++m) {
                const int lr = ai * HALF + wr * 64 + m * 16 + fr, row = rb0 + lr; const float r = tb[lr], gw = tb[256 + lr];
                const f32x4 g0 = silu4(acc[ai][0][m][0] * r), g1 = silu4(acc[ai][0][m][1] * r);
                *(unsigned long long*)(ACT + (size_t)row * FF + u.pn * 128 + cin) = pack8_fp8(g0 * (acc[ai][1][m][0] * gw), g1 * (acc[ai][1][m][1] * gw));
            }
    }
};
struct EpiDownMoe {
    static constexpr bool PERM = true; typedef Prep2 Prep;
    const int* rowinfo; bf16* YY;
    __device__ __forceinline__ Prep prep_load(const Unit& u, int tid) const { Prep p; p.b = 0.f; p.a = __int_as_float(rowinfo[u.pm * BM + (u.hm > 0 ? HALF : 0) + (tid & 255)]); return p; }
    __device__ __forceinline__ void prep_store(const Prep& p, PG8_LAS float* tab, int par, int tid) const { tab[par * 512 + (tid & 255)] = p.a; }
    __device__ __forceinline__ void operator()(const f32x4 (&acc)[2][2][4][2], const Unit& u, const PG8_LAS float* tb, int wr, int wc, int fr, int fq) const {
        const int cin = wc * 32 + 8 * fq, rb0 = u.pm * BM + (u.hm > 0 ? HALF : 0); (void)rb0;
#pragma unroll
        for (int ai = 0; ai < 2; ++ai) if (ai == 0 || u.hm < 0)
#pragma unroll
            for (int m = 0; m < 4; ++m) {
                const int lr = ai * HALF + wr * 64 + m * 16 + fr; const int info = __float_as_int(tb[lr]);
                if (info & 0x8000) { bf16* p = YY + (size_t)(info & 0x3fff) * 2048 + ((info >> 14) & 1) * 1024 + u.pn * BM + cin;
#pragma unroll
                    for (int bj = 0; bj < 2; ++bj) *(u32x4*)(p + bj * HALF) = pack8(acc[ai][bj][m][0], acc[ai][bj][m][1]); }
            }
    }
};
}

#define XB_TMO      128
#define XB_XCNT(j)  (256  + 64 * (j))
#define XB_XSUB(j)  (1280 + 64 * (j))
#define XB_XGEN(j)  (2304 + 64 * (j))
#define XB_TOP      3328
#define XB_TOPGEN   3392
#define XCD_BAR_WORDS 3456
#define XB_SPIN_CAP (1u << 18)
__device__ __forceinline__ unsigned xb_ld(unsigned* p)              { return __hip_atomic_load(p, __ATOMIC_RELAXED, __HIP_MEMORY_SCOPE_AGENT); }
__device__ __forceinline__ unsigned xb_add(unsigned* p, unsigned v) { return __hip_atomic_fetch_add(p, v, __ATOMIC_RELAXED, __HIP_MEMORY_SCOPE_AGENT); }
__device__ __forceinline__ unsigned xb_xcc_id() { return (unsigned)__builtin_amdgcn_s_getreg((3 << 11) | 20) & 0xFu; }
#define XB_SPIN(cond, bar) do { unsigned _sp = 0; while (cond) { __builtin_amdgcn_s_sleep(1); \
    if ((++_sp & 255u) == 0u) { if (xb_ld(&(bar)[XB_TMO])) break; if (_sp > XB_SPIN_CAP) { atomicAdd(&(bar)[XB_TMO], 1u); break; } } } } while (0)
struct XcdBarrier { unsigned* bar; unsigned x; volatile LAS unsigned* st; };
__device__ __forceinline__ XcdBarrier xcd_barrier_post(unsigned* bar, volatile LAS unsigned* st) {
    XcdBarrier b; b.bar = bar; b.x = xb_xcc_id(); b.st = st;
    if (threadIdx.x == 0) (void)xb_add(&bar[XB_XCNT(b.x)], 1u);
    return b;
}
__device__ __forceinline__ void xcd_barrier_complete(unsigned* bar, unsigned x, unsigned& nloc, unsigned& nx) {
    const unsigned G = gridDim.x * gridDim.y * gridDim.z;
    unsigned sum, cnt, mine, sp = 0u;
    for (;;) {
        sum = 0u; cnt = 0u; mine = 0u;
#pragma unroll
        for (unsigned j = 0; j < 16; ++j) { const unsigned c = xb_ld(&bar[XB_XCNT(j)]); sum += c; cnt += (c > 0u) ? 1u : 0u; mine = (j == x) ? c : mine; }
        if (sum == G) break;
        __builtin_amdgcn_s_sleep(1);
        if ((++sp & 255u) == 0u) { if (xb_ld(&bar[XB_TMO])) break; if (sp > XB_SPIN_CAP) { atomicAdd(&bar[XB_TMO], 1u); break; } }
    }
    nloc = mine > 0u ? mine : 1u; nx = cnt > 0u ? cnt : 1u;
}
__device__ __forceinline__ void xcd_barrier(const XcdBarrier& b) {
    asm volatile("s_waitcnt vmcnt(0)" ::: "memory");
    __syncthreads();
    if (threadIdx.x == 0) {
        unsigned* bar = b.bar;
        __builtin_amdgcn_s_waitcnt(0);
        unsigned nloc = b.st[0], nx = b.st[1];
        if (nloc == 0u) { xcd_barrier_complete(bar, b.x, nloc, nx); b.st[0] = nloc; b.st[1] = nx; }
        const unsigned old = xb_add(&bar[XB_XSUB(b.x)], 1u);
        const unsigned gen = old / nloc;
        if (old + 1u == (gen + 1u) * nloc) {
            __builtin_amdgcn_fence(__ATOMIC_RELEASE, "agent");
            asm volatile("s_waitcnt vmcnt(0)" ::: "memory");
            const unsigned og = xb_add(&bar[XB_TOP], 1u);
            const unsigned tg = og / nx;
            if (og + 1u == (tg + 1u) * nx) xb_add(&bar[XB_TOPGEN], 1u);
            else XB_SPIN(xb_ld(&bar[XB_TOPGEN]) == tg, bar);
            __builtin_amdgcn_fence(__ATOMIC_ACQUIRE, "agent");
            xb_add(&bar[XB_XGEN(b.x)], 1u);
            asm volatile("s_waitcnt vmcnt(0)" ::: "memory");
        } else {
            XB_SPIN(xb_ld(&bar[XB_XGEN(b.x)]) == gen, bar);
            __builtin_amdgcn_fence(__ATOMIC_ACQUIRE, "agent");
            asm volatile("s_waitcnt vmcnt(0)" ::: "memory");
        }
    }
    __syncthreads();
}

constexpr int NWAVES = 8, NTHR = 512;
constexpr int RING_BYTES = 131072, MISC_OFF = RING_BYTES, LDS_BYTES = 147456;
constexpr size_t MI_CNT = 1024 * 1024, MI_ROWINFO = 1040 * 1024, MI_ROWG = 1184 * 1024, MI_TILEE = 1328 * 1024;
constexpr int MAXTILES = 136;
constexpr size_t WS_ACTM = WS_WIN0;
constexpr size_t WS_Y1 = WS_XB;
static_assert(WS_ACTM + (size_t)MAXTILES * 256 * FF * 2 <= WS_END, "ACTM fits");

typedef short bf16x8 __attribute__((ext_vector_type(8)));

__device__ __forceinline__ void lds_barrier() { asm volatile("s_waitcnt lgkmcnt(0)" ::: "memory"); __builtin_amdgcn_s_barrier(); asm volatile("" ::: "memory"); }

struct GlaIn { f32x4 la[2][2]; v4u q[2], k[2], v[2][2]; };
__device__ __forceinline__ void gla_chunk_load(int g, GlaIn& in, const bf16* QSg, const bf16* KBg, const bf16* VBg, const float* LAg) {
    const int tid = opaque_tid(), lane = tid & 63, w = tid >> 6; const int bh = g >> 5, n = g & 31, b = bh >> 2, h = bh & 3; const size_t row0 = (size_t)b * T + n * CHUNK;
#pragma unroll
    for (int rr = 0; rr < 2; ++rr) { const size_t row = row0 + 2 * lane + rr;
        in.la[rr][0] = *(const f32x4*)(LAg + row * KEY + h * 64 + 8 * w); in.la[rr][1] = *(const f32x4*)(LAg + row * KEY + h * 64 + 8 * w + 4);
        in.q[rr] = *(const v4u*)(QSg + row * KEY + h * 64 + 8 * w); in.k[rr] = *(const v4u*)(KBg + row * KEY + h * 64 + 8 * w);
        in.v[rr][0] = *(const v4u*)(VBg + row * VAL + h * 128 + 16 * w); in.v[rr][1] = *(const v4u*)(VBg + row * VAL + h * 128 + 16 * w + 8); }
}
__device__ __forceinline__ float bf_lo(unsigned w) { return __uint_as_float(w << 16); }
__device__ __forceinline__ float bf_hi(unsigned w) { return __uint_as_float(w & 0xffff0000u); }
__device__ __forceinline__ void gla_chunk_unit(int g, const GlaIn& in, LAS unsigned char* lds, bf16* QTg, bf16* OIg, float* DSg, float* DECg) {
    const int tid = opaque_tid(), lane = tid & 63, wid = __builtin_amdgcn_readfirstlane(tid >> 6);
    const int bh = g >> 5, n = g & 31, b = bh >> 2, h = bh & 3; const size_t row0 = (size_t)b * T + n * CHUNK;
    LAS bf16* QTl = (LAS bf16*)lds; LAS bf16* KTl = (LAS bf16*)(lds + 18432); LAS bf16* KHT = (LAS bf16*)(lds + 36864); LAS bf16* VT = (LAS bf16*)(lds + 54272); LAS bf16* P = (LAS bf16*)(lds + 89088);
    { float qf[2][8], kf[2][8];
#pragma unroll
      for (int rr = 0; rr < 2; ++rr) { const unsigned qw[4] = {in.q[rr].x, in.q[rr].y, in.q[rr].z, in.q[rr].w}, kw[4] = {in.k[rr].x, in.k[rr].y, in.k[rr].z, in.k[rr].w};
#pragma unroll
          for (int j = 0; j < 4; ++j) { qf[rr][2 * j] = bf_lo(qw[j]); qf[rr][2 * j + 1] = bf_hi(qw[j]); kf[rr][2 * j] = bf_lo(kw[j]); kf[rr][2 * j + 1] = bf_hi(kw[j]); } }
      unsigned qt[2][4], kt[2][4]; float totv[8];
#pragma unroll
      for (int dd = 0; dd < 8; ++dd) { const float c0 = in.la[0][dd >> 2][dd & 3], c1 = c0 + in.la[1][dd >> 2][dd & 3]; float x = c1;
#pragma unroll
          for (int dl = 1; dl < 64; dl <<= 1) { const float y = __shfl_up(x, dl); x += (lane >= dl) ? y : 0.f; }
          const float tot = __int_as_float(__builtin_amdgcn_readlane(__float_as_int(x), 63)), bb0 = x - c1 + c0, bb1 = x; totv[dd] = tot;
          const unsigned q0 = f2bf(qf[0][dd] * __expf(bb0)), q1 = f2bf(qf[1][dd] * __expf(bb1)), k0 = f2bf(kf[0][dd] * __expf(-bb0)), k1 = f2bf(kf[1][dd] * __expf(-bb1));
          if (dd & 1) { qt[0][dd >> 1] |= q0 << 16; qt[1][dd >> 1] |= q1 << 16; kt[0][dd >> 1] |= k0 << 16; kt[1][dd >> 1] |= k1 << 16; } else { qt[0][dd >> 1] = q0; qt[1][dd >> 1] = q1; kt[0][dd >> 1] = k0; kt[1][dd >> 1] = k1; }
          *(LAS unsigned*)(KHT + (8 * wid + dd) * 136 + 2 * lane) = f2bf(kf[0][dd] * __expf(tot - bb0)) | (f2bf(kf[1][dd] * __expf(tot - bb1)) << 16); }
#pragma unroll
      for (int rr = 0; rr < 2; ++rr) { const v4u qv = (v4u){qt[rr][0], qt[rr][1], qt[rr][2], qt[rr][3]};
          *(LAS v4u*)(QTl + (2 * lane + rr) * 72 + 8 * wid) = qv; *(LAS v4u*)(KTl + (2 * lane + rr) * 72 + 8 * wid) = (v4u){kt[rr][0], kt[rr][1], kt[rr][2], kt[rr][3]};
          *(v4u*)(QTg + (row0 + 2 * lane + rr) * KEY + h * 64 + 8 * wid) = qv; }
      if (lane == 0) { *(f32x4*)(DECg + (size_t)g * 64 + 8 * wid) = (f32x4){__expf(totv[0]), __expf(totv[1]), __expf(totv[2]), __expf(totv[3])}; *(f32x4*)(DECg + (size_t)g * 64 + 8 * wid + 4) = (f32x4){__expf(totv[4]), __expf(totv[5]), __expf(totv[6]), __expf(totv[7])}; } }
    { const unsigned v0[8] = {in.v[0][0].x, in.v[0][0].y, in.v[0][0].z, in.v[0][0].w, in.v[0][1].x, in.v[0][1].y, in.v[0][1].z, in.v[0][1].w};
      const unsigned v1[8] = {in.v[1][0].x, in.v[1][0].y, in.v[1][0].z, in.v[1][0].w, in.v[1][1].x, in.v[1][1].y, in.v[1][1].z, in.v[1][1].w};
#pragma unroll
      for (int j = 0; j < 8; ++j) { *(LAS unsigned*)(VT + (16 * wid + 2 * j) * 136 + 2 * lane) = (v0[j] & 0xffffu) | (v1[j] << 16); *(LAS unsigned*)(VT + (16 * wid + 2 * j + 1) * 136 + 2 * lane) = (v0[j] >> 16) | (v1[j] & 0xffff0000u); } }
    lds_barrier();
    const int fr = lane & 15, fq = lane >> 4, it = wid;
    { const bf16x8 qb0 = *(const LAS bf16x8*)(QTl + (it * 16 + fr) * 72 + fq * 8), qb1 = *(const LAS bf16x8*)(QTl + (it * 16 + fr) * 72 + 32 + fq * 8);
      const int i = it * 16 + fr;
      for (int jt = 0; jt <= it; ++jt) {
          const bf16x8 ka0 = *(const LAS bf16x8*)(KTl + (jt * 16 + fr) * 72 + fq * 8), ka1 = *(const LAS bf16x8*)(KTl + (jt * 16 + fr) * 72 + 32 + fq * 8);
          f32x4 a = (f32x4){0.f, 0.f, 0.f, 0.f};
          a = __builtin_amdgcn_mfma_f32_16x16x32_bf16(ka0, qb0, a, 0, 0, 0); a = __builtin_amdgcn_mfma_f32_16x16x32_bf16(ka1, qb1, a, 0, 0, 0);
          const int j0 = jt * 16 + 4 * fq; unsigned long long w = 0ull;
#pragma unroll
          for (int r = 0; r < 4; ++r) { const float v = (j0 + r <= i) ? a[r] : 0.f; w |= (unsigned long long)f2bf(v) << (16 * r); }
          *(LAS unsigned long long*)(P + i * 136 + j0) = w; }
      if (!(it & 1)) *(LAS unsigned long long*)(P + i * 136 + (it + 1) * 16 + 4 * fq) = 0ull; }
    lds_barrier();
    { const int nks = (it >> 1) + 1; bf16x8 pb[4];
#pragma unroll
      for (int kk = 0; kk < 4; ++kk) pb[kk] = *(const LAS bf16x8*)(P + (it * 16 + fr) * 136 + ((kk < nks) ? kk : 0) * 32 + fq * 8);
#pragma unroll
      for (int vt = 0; vt < 8; ++vt) { f32x4 o = (f32x4){0.f, 0.f, 0.f, 0.f};
#pragma unroll
          for (int kk = 0; kk < 4; ++kk) if (kk < nks) o = __builtin_amdgcn_mfma_f32_16x16x32_bf16(*(const LAS bf16x8*)(VT + (vt * 16 + fr) * 136 + kk * 32 + fq * 8), pb[kk], o, 0, 0, 0);
          *(unsigned long long*)(OIg + (row0 + it * 16 + fr) * VAL + h * 128 + vt * 16 + 4 * fq) = (unsigned long long)pk2(o[0], o[1]) | ((unsigned long long)pk2(o[2], o[3]) << 32); }
      const int dt = wid & 3; bf16x8 ha[4];
#pragma unroll
      for (int kk = 0; kk < 4; ++kk) ha[kk] = *(const LAS bf16x8*)(KHT + (dt * 16 + fr) * 136 + kk * 32 + fq * 8);
#pragma unroll
      for (int vv = 0; vv < 4; ++vv) { const int vt = 4 * (wid >> 2) + vv; f32x4 sacc = (f32x4){0.f, 0.f, 0.f, 0.f};
#pragma unroll
          for (int kk = 0; kk < 4; ++kk) sacc = __builtin_amdgcn_mfma_f32_16x16x32_bf16(ha[kk], *(const LAS bf16x8*)(VT + (vt * 16 + fr) * 136 + kk * 32 + fq * 8), sacc, 0, 0, 0);
          *(f32x4*)(DSg + ((size_t)g * 128 + vt * 16 + fr) * 64 + dt * 16 + 4 * fq) = sacc; } }
    lds_barrier();
}

__device__ __forceinline__ void conv_unit(int cu, LAS unsigned char* lds, const bf16* UBg, const float* cw, const float* cb, const float* cnw, const float* cnb, bf16* MIXg) {
    const int tid = opaque_tid(), c = tid; const int row0 = cu * 32, t0 = row0 & (T - 1);
    LAS bf16* U = (LAS bf16*)lds; LAS float* Y = (LAS float*)(lds + 63488); LAS float* STAT = (LAS float*)(lds + 129536);
    { v4u uv[8];
#pragma unroll
      for (int k = 0; k < 8; ++k) { const int e = min(tid + 512 * k, 62 * 64 - 1), r = e >> 6; const bool ok = (t0 + r >= 30);
          uv[k] = *(const v4u*)(UBg + (size_t)(ok ? row0 - 30 + r : row0) * CCH + (e & 63) * 8); if (!ok) uv[k] = (v4u){0u, 0u, 0u, 0u}; }
#pragma unroll
      for (int k = 0; k < 8; ++k) { const int e = min(tid + 512 * k, 62 * 64 - 1); *(LAS v4u*)(U + (size_t)e * 8) = uv[k]; } }
    float w[CW];
#pragma unroll
    for (int k = 0; k < CW; ++k) w[k] = cw[k * CCH + c];
    float y[32]; const float bias = cb[c];
#pragma unroll
    for (int i = 0; i < 32; ++i) y[i] = bias;
    lds_barrier();
    float uu[62];
#pragma unroll
    for (int p = 0; p < 62; ++p) uu[p] = bf2f(U[p * 512 + c]);
#pragma clang loop unroll(full)
    for (int k = 0; k < CW; ++k) {
#pragma clang loop unroll(full)
        for (int i = 0; i < 32; ++i) y[i] = fmaf(uu[i + k], w[k], y[i]);
    }
#pragma unroll
    for (int i = 0; i < 32; ++i) Y[i * 516 + c] = y[i];
    lds_barrier();
    { const int tt = tid >> 4, part = tid & 15; float s = 0.f, q = 0.f;
#pragma unroll
      for (int k = 0; k < 32; ++k) { const float v = Y[tt * 516 + part * 32 + ((k + part) & 31)]; s += v; q += v * v; }
#pragma unroll
      for (int o = 1; o < 16; o <<= 1) { s += __shfl_xor(s, o); q += __shfl_xor(q, o); }
      if (part == 0) { const float mean = s * (1.f / CCH); const float var = fmaxf(q * (1.f / CCH) - mean * mean, 0.f); STAT[tt * 2] = mean; STAT[tt * 2 + 1] = rsqrtf(var + EPS); } }
    lds_barrier();
    const float gw = cnw[c], gb = cnb[c];
#pragma unroll
    for (int i = 0; i < 32; ++i) { const float z = (y[i] - STAT[i * 2]) * STAT[i * 2 + 1] * gw + gb; U[i * 512 + c] = (bf16)f2bf(z * __builtin_amdgcn_rcpf(1.f + __expf(-z))); }
    lds_barrier();
#pragma unroll
    for (int k = 0; k < 4; ++k) { const int e = tid + 512 * k, r = e >> 6; *(v4u*)(MIXg + (size_t)(row0 + r) * D + 512 + (e & 63) * 8) = *(const LAS v4u*)(U + (size_t)e * 8); }
    lds_barrier();
}

__device__ __forceinline__ void gla_out_unit(int g, LAS unsigned char* lds, const bf16* QTg, const bf16* SPg, const bf16* OIg, const bf16* SGg, const float* gnw, bf16* MIXg) {
    const int tid = opaque_tid(), lane = tid & 63, wid = __builtin_amdgcn_readfirstlane(tid >> 6);
    const int bh = g >> 5, n = g & 31, b = bh >> 2, h = bh & 3; const size_t row0 = (size_t)b * T + n * CHUNK;
    LAS bf16* QTl = (LAS bf16*)lds; LAS bf16* ST = (LAS bf16*)(lds + 18432);
    { v4u qv[2], sv[2];
#pragma unroll
      for (int k = 0; k < 2; ++k) { const int e = tid + 512 * k, i = e >> 3, ds = (e & 7) * 8; qv[k] = *(const v4u*)(QTg + (row0 + i) * KEY + h * 64 + ds); sv[k] = *(const v4u*)(SPg + ((size_t)g * 128 + i) * 64 + ds); }
#pragma unroll
      for (int k = 0; k < 2; ++k) { const int e = tid + 512 * k, i = e >> 3, ds = (e & 7) * 8; *(LAS v4u*)(QTl + i * 72 + ds) = qv[k]; *(LAS v4u*)(ST + i * 72 + ds) = sv[k]; } }
    const int fr = lane & 15, fq = lane >> 4, it = wid; const size_t rowi = row0 + it * 16 + fr;
    unsigned long long oiv[8], sgv[8]; f32x4 gwv[8];
#pragma unroll
    for (int vt = 0; vt < 8; ++vt) { const int v0 = vt * 16 + 4 * fq; oiv[vt] = *(const unsigned long long*)(OIg + rowi * VAL + h * 128 + v0); sgv[vt] = *(const unsigned long long*)(SGg + rowi * VAL + h * 128 + v0); gwv[vt] = *(const f32x4*)(gnw + v0); }
    lds_barrier();
    const bf16x8 qb0 = *(const LAS bf16x8*)(QTl + (it * 16 + fr) * 72 + fq * 8), qb1 = *(const LAS bf16x8*)(QTl + (it * 16 + fr) * 72 + 32 + fq * 8);
    f32x4 o[8]; float ss = 0.f;
#pragma unroll
    for (int vt = 0; vt < 8; ++vt) {
        const bf16x8 sa0 = *(const LAS bf16x8*)(ST + (vt * 16 + fr) * 72 + fq * 8), sa1 = *(const LAS bf16x8*)(ST + (vt * 16 + fr) * 72 + 32 + fq * 8);
        f32x4 a = (f32x4){0.f, 0.f, 0.f, 0.f};
        a = __builtin_amdgcn_mfma_f32_16x16x32_bf16(sa0, qb0, a, 0, 0, 0); a = __builtin_amdgcn_mfma_f32_16x16x32_bf16(sa1, qb1, a, 0, 0, 0);
        const unsigned long long oi = oiv[vt];
        a[0] += bf_lo((unsigned)oi); a[1] += bf_hi((unsigned)oi); a[2] += bf_lo((unsigned)(oi >> 32)); a[3] += bf_hi((unsigned)(oi >> 32));
        o[vt] = a; ss += (a[0] * a[0] + a[1] * a[1]) + (a[2] * a[2] + a[3] * a[3]); }
    ss += __shfl_xor(ss, 16); ss += __shfl_xor(ss, 32);
    const float r = rsqrtf(ss * (1.f / DV) + EPS);
#pragma unroll
    for (int vt = 0; vt < 8; ++vt) { const int v0 = vt * 16 + 4 * fq; const f32x4 gw = gwv[vt]; const unsigned long long sg = sgv[vt];
        *(unsigned long long*)(MIXg + rowi * D + h * 128 + v0) = (unsigned long long)pk2(o[vt][0] * r * gw[0] * bf_lo((unsigned)sg), o[vt][1] * r * gw[1] * bf_hi((unsigned)sg))
            | ((unsigned long long)pk2(o[vt][2] * r * gw[2] * bf_lo((unsigned)(sg >> 32)), o[vt][3] * r * gw[3] * bf_hi((unsigned)(sg >> 32))) << 32); }
    lds_barrier();
}

struct Args { Inputs I; float* out; unsigned char* ws; int ph_lo, ph_hi; };
__global__ void __launch_bounds__(NTHR, 2) mk_fwd(Args args) {
    extern __shared__ __attribute__((aligned(16))) unsigned char lds_raw[];
    LAS unsigned char* lds = (LAS unsigned char*)lds_raw;
    const int G = gridDim.x, bx = blockIdx.x;
#define PH_IDS const int tid = opaque_tid(), lane = tid & 63, wave = __builtin_amdgcn_readfirstlane(tid >> 6); (void)lane; (void)wave
    unsigned char* ws = args.ws; const Inputs& I = args.I; float* XA = args.out;
#define XB ((bf16*)(ws + WS_XB))
#define QS ((bf16*)(ws + WS_QS))
#define KB ((bf16*)(ws + WS_KB))
#define VB ((bf16*)(ws + WS_VB))
#define SG ((bf16*)(ws + WS_SG))
#define UB ((bf16*)(ws + WS_UB))
#define MIX ((bf16*)(ws + WS_MIX))
#define ACT ((bf16*)(ws + WS_ACT))
#define QT ((bf16*)(ws + WS_QT))
#define OI ((bf16*)(ws + WS_OI))
#define SP ((bf16*)(ws + WS_SP))
#define ACTM ((bf16*)(ws + WS_ACTM))
#define Y1 ((bf16*)(ws + WS_Y1))
#define SSQ ((float*)(ws + WS_SSQ))
#define LA ((float*)(ws + WS_LA))
#define DS ((float*)(ws + WS_DS))
#define DEC ((float*)(ws + WS_MISC + MI_DEC))
#define ROWG ((float*)(ws + WS_MISC + MI_ROWG))
#define SEL ((int*)(ws + WS_MISC + MI_SEL))
#define CNT ((int*)(ws + WS_MISC + MI_CNT))
#define ROWINFO ((int*)(ws + WS_MISC + MI_ROWINFO))
#define TILEE ((int*)(ws + WS_MISC + MI_TILEE))
    const int lo = args.ph_lo, hi = args.ph_hi;
    if (threadIdx.x < 4) ((LAS unsigned*)(lds + MISC_OFF))[threadIdx.x] = 0u;
    __syncthreads();
    XcdBarrier bar; bar.bar = (unsigned*)(ws + WS_CTL) + 4096; bar.x = 0; bar.st = nullptr;
    if (hi - lo > 1) bar = xcd_barrier_post((unsigned*)(ws + WS_CTL) + 4096, (volatile LAS unsigned*)(lds + MISC_OFF));
#ifndef PHMASK
#define PHMASK 0x3ffff
#endif
#define IN(k) (((PHMASK >> ((k) >= 8 && (k) <= 12 ? (k) - 7 : (k))) & 1) && lo <= (k) && (k) < hi)
#define SEAM(k) do { if (IN(k) && IN((k) + 1)) xcd_barrier(bar); } while (0)

    if (IN(0)) { PH_IDS;
        LAS float* scr = (LAS float*)(lds + wave * 16384); const int gw = bx * NWAVES + wave, NGW = G * NWAVES;
        cvt_all(I, ws, gw, NGW, scr, lane);
        for (int idx = bx * NTHR + tid; idx < 2 * 256 * 1024; idx += G * NTHR) cvt_gate_elem(I, ws, idx);
        for (int m = gw; m < M; m += NGW) row_to_xb(I.x + (size_t)m * D, XB + (size_t)m * D, SSQ + (size_t)m * 16, lane);
        __syncthreads();
    }
    SEAM(0);
    for (int l = 0; l < 2; ++l) {
        const int pb = 1 + 7 * l;
        const bf16* Win = (const bf16*)(ws + (l ? WS_WIN1 : WS_WIN0)); const bf16* Wout = (const bf16*)(ws + (l ? WS_WOUT1 : WS_WOUT0));
        if (IN(pb)) {
            pg8::StaticOrder<NIN / 256> S; S.init(M / 256, G, bx, Win);
            pg8::EpiIn E{SSQ, I.b_gate + l * KEY, QS, KB, VB, SG, UB, LA};
            pg8::gemm_phase<pg8::EpiIn, pg8::StaticOrder<NIN / 256>, true, true>(lds, (LAS float*)(lds + MISC_OFF + 64), XB, D, S, E);
        }
        SEAM(pb);
        if (IN(pb + 1)) {
            constexpr int NGU_ = NB * H * NCH;
            for (int u = bx; u < NGU_; u += G) { GlaIn gin; gla_chunk_load(u, gin, QS, KB, VB, LA); gla_chunk_unit(u, gin, lds, QT, OI, DS, DEC); }
            for (int u = bx; u < 512; u += G) conv_unit(u, lds, UB, I.conv_w + l * CW * CCH, I.conv_b + l * CCH, I.cn_w + l * CCH, I.cn_b + l * CCH, MIX);
        }
        SEAM(pb + 1);
        if (IN(pb + 2)) { PH_IDS;
            for (int idx = bx * NTHR + tid; idx < NB * H * DV * DK; idx += G * NTHR) {
                const int bh = idx >> 13, vd = idx & 8191, d = idx & 63; float S = 0.f;
                const float* dsp = DS + (size_t)bh * NCH * 8192 + vd; const float* dcp = DEC + (size_t)bh * NCH * 64 + d; bf16* spp = SP + (size_t)bh * NCH * 8192 + vd;
                for (int nb = 0; nb < NCH; nb += 16) {
                    float dv[16], av[16];
#pragma unroll
                    for (int i = 0; i < 16; ++i) { dv[i] = dsp[(size_t)(nb + i) * 8192]; av[i] = dcp[(nb + i) * 64]; }
#pragma unroll
                    for (int i = 0; i < 16; ++i) { spp[(size_t)(nb + i) * 8192] = (bf16)f2bf(S); S = av[i] * S + dv[i]; }
                }
            }
        }
        SEAM(pb + 2);
        if (IN(pb + 3)) {
            for (int u = bx; u < NB * H * NCH; u += G) gla_out_unit(u, lds, QT, SP, OI, SG, I.gla_norm_w + l * DV, MIX);
        }
        SEAM(pb + 3);
        if (IN(pb + 4)) {
            pg8::StaticOrder<D / 256> S; S.init(M / 256, G, bx, Wout);
            pg8::EpiRes E{XB, SSQ, l == 1 ? ws + WS_XB8 : nullptr};
            pg8::gemm_phase<pg8::EpiRes, pg8::StaticOrder<D / 256>, true, true>(lds, (LAS float*)(lds + MISC_OFF + 64), MIX, D, S, E);
        }
        SEAM(pb + 4);
        if (l == 0) {
            if (IN(6)) {
                pg8::StaticOrder<NGU / 256, false> S; S.init(M / 256, G, bx, (const bf16*)(ws + WS_WDGU));
                pg8::EpiUp E{SSQ, ACT};
                pg8::gemm_phase<pg8::EpiUp, pg8::StaticOrder<NGU / 256, false>, true, true>(lds, (LAS float*)(lds + MISC_OFF + 64), XB, D, S, E);
            }
            SEAM(6);
            if (IN(7)) {
                pg8::StaticOrder<D / 256> S; S.init(M / 256, G, bx, (const bf16*)(ws + WS_WDD));
                pg8::EpiRes E{XB, SSQ, nullptr};
                pg8::gemm_phase<pg8::EpiRes, pg8::StaticOrder<D / 256>, true, true>(lds, (LAS float*)(lds + MISC_OFF + 64), ACT, FF, S, E);
            }
            SEAM(7);
        }
    }
    if (IN(13)) { PH_IDS;
        LAS int* sel = (LAS int*)lds;
        f32x4 wq[4][4][2];
#pragma unroll
        for (int j = 0; j < 4; ++j)
#pragma unroll
            for (int c = 0; c < 4; ++c) { const int k = 256 * j + 4 * lane + c; const float lw = I.ln2_w[D + k]; const f32x4* wp = (const f32x4*)(I.w_router + (size_t)k * NE); wq[j][c][0] = wp[0] * lw; wq[j][c][1] = wp[1] * lw; }
        for (int rb = bx; rb < M / 64; rb += G) {
            unsigned long long xw[8][4];
#pragma unroll
            for (int k8 = 0; k8 < 8; ++k8) { const unsigned long long* xr = (const unsigned long long*)(XB + (size_t)(rb * 64 + wave * 8 + k8) * D) + lane;
#pragma unroll
                for (int j = 0; j < 4; ++j) xw[k8][j] = xr[64 * j]; }
            float val[9][8];
#pragma unroll
            for (int k8 = 0; k8 < 8; ++k8) {
                f32x4 l0 = (f32x4){0.f, 0.f, 0.f, 0.f}, l1 = l0; float ss = 0.f;
#pragma unroll
                for (int j = 0; j < 4; ++j) { const unsigned long long w8 = xw[k8][j];
                    const float xe[4] = {__uint_as_float((unsigned)(w8 << 16)), __uint_as_float((unsigned)w8 & 0xffff0000u), __uint_as_float((unsigned)(w8 >> 32) << 16), __uint_as_float((unsigned)(w8 >> 32) & 0xffff0000u)};
#pragma unroll
                    for (int c = 0; c < 4; ++c) { const float x = xe[c]; ss += x * x; l0 += wq[j][c][0] * x; l1 += wq[j][c][1] * x; } }
#pragma unroll
                for (int e = 0; e < 4; ++e) { val[e][k8] = l0[e]; val[4 + e][k8] = l1[e]; }
                val[8][k8] = ss;
            }
            const bool b5 = (lane & 32) != 0, b4 = (lane & 16) != 0, b3 = (lane & 8) != 0;
            float v1[9];
#pragma unroll
            for (int q = 0; q < 9; ++q) { float v4[4], v2[2];
#pragma unroll
                for (int t = 0; t < 4; ++t) { const float keep = b5 ? val[q][t + 4] : val[q][t], send = b5 ? val[q][t] : val[q][t + 4]; v4[t] = keep + __shfl_xor(send, 32); }
#pragma unroll
                for (int t = 0; t < 2; ++t) { const float keep = b4 ? v4[t + 2] : v4[t], send = b4 ? v4[t] : v4[t + 2]; v2[t] = keep + __shfl_xor(send, 16); }
                const float keep = b3 ? v2[1] : v2[0], send = b3 ? v2[0] : v2[1]; float x = keep + __shfl_xor(send, 8);
                x += __shfl_xor(x, 4); x += __shfl_xor(x, 2); x += __shfl_xor(x, 1); v1[q] = x; }
            { const int tk = lane >> 3, m = rb * 64 + wave * 8 + tk; const float r = rsqrtf(v1[8] * (1.f / D) + EPS);
                float lg[NE];
#pragma unroll
                for (int e = 0; e < NE; ++e) lg[e] = v1[e] * r;
                int e1 = 0; float vv1 = lg[0];
#pragma unroll
                for (int e = 1; e < NE; ++e) if (lg[e] > vv1) { vv1 = lg[e]; e1 = e; }
                int e2 = -1; float vv2 = -3.0e38f;
#pragma unroll
                for (int e = 0; e < NE; ++e) if (e != e1 && lg[e] > vv2) { vv2 = lg[e]; e2 = e; }
                const float p2 = __expf(vv2 - vv1), g1 = 1.f / (1.f + p2), g2 = p2 / (1.f + p2);
                if ((lane & 7) == 0) { SEL[m * 4 + 0] = e1; SEL[m * 4 + 1] = e2; SEL[m * 4 + 2] = __float_as_int(g1); SEL[m * 4 + 3] = __float_as_int(g2); sel[(wave * 8 + tk) * 2] = e1; sel[(wave * 8 + tk) * 2 + 1] = e2; }
            }
            __syncthreads();
            if (wave == 0) { const int e1 = sel[lane * 2], e2 = sel[lane * 2 + 1];
#pragma unroll
                for (int e = 0; e < NE; ++e) { const int cnt = __popcll(__ballot(e1 == e)) + __popcll(__ballot(e2 == e)); if (lane == 0) CNT[rb * NE + e] = cnt; } }
            __syncthreads();
        }
    }
    SEAM(13);
    if (IN(14)) { PH_IDS;
        LAS int* tab = (LAS int*)lds;
        for (int rb = bx; rb < M / 64; rb += G) {
            if (wave == 0) {
#pragma unroll
                for (int e = 0; e < NE; ++e) { int tot = 0, pre = 0;
#pragma unroll
                    for (int q = 0; q < 4; ++q) { const int r2 = lane + 64 * q; const int c = CNT[r2 * NE + e]; tot += c; pre += (r2 < rb) ? c : 0; }
#pragma unroll
                    for (int o = 1; o < 64; o <<= 1) { tot += __shfl_xor(tot, o); pre += __shfl_xor(pre, o); }
                    if (lane == 0) { tab[e] = tot; tab[16 + e] = pre; } }
                asm volatile("s_waitcnt lgkmcnt(0)" ::: "memory");
                if (lane == 0) { int off = 0;
                    for (int e = 0; e < NE; ++e) { tab[8 + e] = off; tab[16 + e] += off; off += ((tab[e] + 255) >> 8) << 8; }
                    tab[24] = off >> 8; }
                asm volatile("s_waitcnt lgkmcnt(0)" ::: "memory");
                const int m = rb * 64 + lane; const int e1 = SEL[m * 4], e2 = SEL[m * 4 + 1]; const float g1 = __int_as_float(SEL[m * 4 + 2]), g2 = __int_as_float(SEL[m * 4 + 3]);
                const unsigned long long lt = (1ull << lane) - 1ull;
#pragma unroll
                for (int e = 0; e < NE; ++e) { const unsigned long long m1 = __ballot(e1 == e), m2 = __ballot(e2 == e); const int base = tab[16 + e];
                    if (e1 == e) { const int pos = base + __popcll(m1 & lt); ROWINFO[pos] = m | 0x8000; ROWG[pos] = g1; }
                    if (e2 == e) { const int pos = base + __popcll(m1) + __popcll(m2 & lt); ROWINFO[pos] = m | 0x4000 | 0x8000; ROWG[pos] = g2; } }
                if (rb < NE) { const int tot = tab[rb], off = tab[8 + rb], pad = ((tot + 255) >> 8) << 8;
                    for (int p = tot + lane; p < pad; p += 64) { ROWINFO[off + p] = 0; ROWG[off + p] = 0.f; }
                    for (int tI = lane; tI < (pad >> 8); tI += 64) TILEE[(off >> 8) + tI] = rb; }
                if (rb == 0 && lane == 0) TILEE[255] = tab[24];
            }
            __syncthreads();
        }
    }
    SEAM(14);
    if (IN(15)) {
        const int NT = __builtin_amdgcn_readfirstlane(__hip_atomic_load(TILEE + 255, __ATOMIC_RELAXED, __HIP_MEMORY_SCOPE_AGENT));
        LAS int* tile_l = (LAS int*)(lds + MISC_OFF + 8192);
        if (threadIdx.x < MAXTILES) tile_l[threadIdx.x] = TILEE[threadIdx.x];
        __syncthreads();
        pg8::MoeOrder<true, NGU / 256, false> S; S.init(NT, G, bx, ws + WS_WMGU, (size_t)NGU * D, tile_l, ROWINFO);
        pg8::EpiUpMoe E{SSQ, ROWINFO, ROWG, ws + WS_ACTM};
        pg8::gemm_phase<pg8::EpiUpMoe, pg8::MoeOrder<true, NGU / 256, false>, true, true, true, 0x79797979, 0x7f7f7f7f>(lds, (LAS float*)(lds + MISC_OFF + 64), ws + WS_XB8, D, S, E);
    }
    SEAM(15);
    if (IN(16)) {
        const int NT = __builtin_amdgcn_readfirstlane(__hip_atomic_load(TILEE + 255, __ATOMIC_RELAXED, __HIP_MEMORY_SCOPE_AGENT));
        LAS int* tile_l = (LAS int*)(lds + MISC_OFF + 8192);
        if (threadIdx.x < MAXTILES) tile_l[threadIdx.x] = TILEE[threadIdx.x];
        __syncthreads();
        pg8::MoeOrder<false, D / 256, false> S; S.init(NT, G, bx, ws + WS_WMD, (size_t)D * FF, tile_l, ROWINFO);
        pg8::EpiDownMoe E{ROWINFO, (bf16*)XA};
        pg8::gemm_phase<pg8::EpiDownMoe, pg8::MoeOrder<false, D / 256, false>, true, true, true, 0x79797979, 0x7b7b7b7b>(lds, (LAS float*)(lds + MISC_OFF + 64), ws + WS_ACTM, FF, S, E);
    }
    SEAM(16);
    if (IN(17)) { PH_IDS;
        const int gw = bx * NWAVES + wave, NGW = G * NWAVES;
        f32x4 wv[4];
#pragma unroll
        for (int j = 0; j < 4; ++j) wv[j] = ((const f32x4*)I.final_w)[lane + 64 * j];
        unsigned long long a0[4], a1[4], a2[4];
        int m = gw;
        if (m < M) { const unsigned long long* y0 = (const unsigned long long*)((const bf16*)XA + (size_t)m * 2048) + lane; const unsigned long long* xb = (const unsigned long long*)(XB + (size_t)m * D) + lane;
#pragma unroll
            for (int j = 0; j < 4; ++j) { a0[j] = y0[64 * j]; a1[j] = y0[256 + 64 * j]; a2[j] = xb[64 * j]; } }
        while (m < M) { const int mn = m + NGW; unsigned long long b0[4], b1[4], b2[4];
            if (mn < M) { const unsigned long long* y0 = (const unsigned long long*)((const bf16*)XA + (size_t)mn * 2048) + lane; const unsigned long long* xb = (const unsigned long long*)(XB + (size_t)mn * D) + lane;
#pragma unroll
                for (int j = 0; j < 4; ++j) { b0[j] = y0[64 * j]; b1[j] = y0[256 + 64 * j]; b2[j] = xb[64 * j]; } }
            f32x4 v[4]; float s = 0.f;
#pragma unroll
            for (int j = 0; j < 4; ++j) {
                v[j][0] = __uint_as_float((unsigned)(a0[j] << 16)) + __uint_as_float((unsigned)(a1[j] << 16)) + __uint_as_float((unsigned)(a2[j] << 16));
                v[j][1] = __uint_as_float((unsigned)a0[j] & 0xffff0000u) + __uint_as_float((unsigned)a1[j] & 0xffff0000u) + __uint_as_float((unsigned)a2[j] & 0xffff0000u);
                v[j][2] = __uint_as_float((unsigned)(a0[j] >> 32) << 16) + __uint_as_float((unsigned)(a1[j] >> 32) << 16) + __uint_as_float((unsigned)(a2[j] >> 32) << 16);
                v[j][3] = __uint_as_float((unsigned)(a0[j] >> 32) & 0xffff0000u) + __uint_as_float((unsigned)(a1[j] >> 32) & 0xffff0000u) + __uint_as_float((unsigned)(a2[j] >> 32) & 0xffff0000u);
                s += (v[j].x * v[j].x + v[j].y * v[j].y) + (v[j].z * v[j].z + v[j].w * v[j].w); }
            const float r = rsqrtf(wave_sum(s) * (1.f / D) + EPS);
            f32x4* xr = (f32x4*)(XA + (size_t)m * D) + lane;
#pragma unroll
            for (int j = 0; j < 4; ++j) xr[64 * j] = v[j] * r * wv[j];
#pragma unroll
            for (int j = 0; j < 4; ++j) { a0[j] = b0[j]; a1[j] = b1[j]; a2[j] = b2[j]; }
            m = mn; }
    }
#undef IN
#undef SEAM
#undef PH_IDS
#undef XB
#undef QS
#undef KB
#undef VB
#undef SG
#undef UB
#undef MIX
#undef ACT
#undef QT
#undef OI
#undef SP
#undef ACTM
#undef Y1
#undef SSQ
#undef LA
#undef DS
#undef DEC
#undef ROWG
#undef SEL
#undef CNT
#undef ROWINFO
#undef TILEE
}
extern "C" void kernel_launch(void* const* d_in, const int* in_sizes, int n_in, void* d_out, int out_size, void* d_ws, size_t ws_size, hipStream_t stream) {
    static int grid = 0;
    if (grid == 0) {
        if (n_in != 20 || in_sizes[0] != M * D || out_size != M * D || ws_size < WS_END) { fprintf(stderr, "kernel_launch: unexpected shapes/workspace (n_in %d, ws %zu, need %zu)\n", n_in, ws_size, (size_t)WS_END); grid = -1; return; }
        int dev = 0, cus = 0, per_cu = 0;
        if (hipGetDevice(&dev) != hipSuccess || hipDeviceGetAttribute(&cus, hipDeviceAttributeMultiprocessorCount, dev) != hipSuccess) { grid = -1; return; }
        if (hipFuncSetAttribute((const void*)mk_fwd, hipFuncAttributeMaxDynamicSharedMemorySize, LDS_BYTES) != hipSuccess) { fprintf(stderr, "kernel_launch: hipFuncSetAttribute failed\n"); grid = -1; return; }
        if (hipOccupancyMaxActiveBlocksPerMultiprocessor(&per_cu, (const void*)mk_fwd, NTHR, LDS_BYTES) != hipSuccess || per_cu < 1) { fprintf(stderr, "kernel_launch: occupancy query says %d\n", per_cu); per_cu = 1; }
        (void)hipGetLastError();
        grid = cus;
    }
    if (grid < 0) return;
    unsigned char* ws = (unsigned char*)d_ws;
    (void)hipMemsetAsync(ws + WS_CTL, 0, 32768, stream);
    Args a{};
    { const float** p = (const float**)&a.I; for (int i = 0; i < 20; ++i) p[i] = (const float*)d_in[i]; }
    a.out = (float*)d_out; a.ws = ws; a.ph_lo = 0; a.ph_hi = 18;
    hipLaunchKernelGGL(mk_fwd, dim3(grid), dim3(NTHR), LDS_BYTES, stream, a);
}
```

```cpp
#include <hip/hip_runtime.h>
#include <cstdio>
#include <cstdint>

typedef unsigned short bf16;
typedef unsigned v4u __attribute__((ext_vector_type(4)));
typedef float f32x4 __attribute__((ext_vector_type(4)));
#define LAS __attribute__((address_space(3)))

constexpr int D = 1024, NB = 4, T = 4096, M = NB * T;
constexpr int H = 4, DK = 64, DV = 128, KEY = 256, VAL = 512, RANK = 16, CCH = 512, CW = 31;
constexpr int INC = 2576, NIN = 2816;
constexpr int FF = 2816, NE = 8, NGU = 2 * FF;
constexpr float EPS = 1e-6f;
constexpr int CHUNK = 128, NCH = T / CHUNK;

constexpr size_t MiB = 1u << 20;
constexpr size_t WS_CTL = 0;
constexpr size_t WS_WMGU = 2 * MiB;
constexpr size_t WS_WMD = 46 * MiB;
constexpr size_t WS_XB8 = 68 * MiB;
constexpr size_t WS_WIN1 = 134 * MiB;
constexpr size_t WS_WOUT1 = 140 * MiB;
constexpr size_t WS_XB = 142 * MiB;
constexpr size_t WS_SSQ = 174 * MiB;
constexpr size_t WS_MISC = 175 * MiB;
constexpr size_t WS_WIN0 = 177 * MiB;
constexpr size_t WS_WOUT0 = 183 * MiB;
constexpr size_t WS_WDGU = 185 * MiB;
constexpr size_t WS_WDD = 196 * MiB;
constexpr size_t WS_TMP = 202 * MiB;
constexpr size_t WS_QS = WS_TMP, WS_KB = WS_TMP + 8 * MiB, WS_VB = WS_TMP + 16 * MiB, WS_SG = WS_TMP + 32 * MiB, WS_LA = WS_TMP + 48 * MiB, WS_UB = WS_TMP + 64 * MiB;
constexpr size_t WS_QT = WS_TMP + 80 * MiB, WS_OI = WS_TMP + 88 * MiB, WS_DS = WS_TMP + 104 * MiB, WS_SP = WS_TMP + 136 * MiB, WS_MIX = WS_TMP + 152 * MiB;
constexpr size_t WS_ACT = WS_TMP;
constexpr size_t WS_END = WS_TMP + 184 * MiB;
constexpr size_t MI_SEL = 0, MI_DEC = 768 * 1024;

__device__ __forceinline__ float bf2f(bf16 b) { return __uint_as_float(((unsigned)b) << 16); }
__device__ __forceinline__ unsigned f2bf(float f) { unsigned u = __float_as_uint(f); return (u + 0x7fffu + ((u >> 16) & 1u)) >> 16; }
__device__ __forceinline__ unsigned pk2(float lo, float hi) { return f2bf(lo) | (f2bf(hi) << 16); }
__device__ __forceinline__ float sigmoidf_(float x) { return 1.f / (1.f + __expf(-x)); }
__device__ __forceinline__ float siluf_(float x) { return x / (1.f + __expf(-x)); }
__device__ __forceinline__ float logsigf_(float x) { return fminf(x, 0.f) - log1pf(__expf(-fabsf(x))); }
__device__ __forceinline__ float wave_sum(float v) {
#pragma unroll
    for (int o = 1; o < 64; o <<= 1) v += __shfl_xor(v, o);
    return v;
}
__device__ __forceinline__ float row_rstd(const float* ssq, int row) {
    const f32x4* p = (const f32x4*)(ssq + (size_t)row * 16);
    f32x4 a = p[0], b = p[1], c = p[2], d = p[3];
    float s = ((a.x + a.y) + (a.z + a.w)) + ((b.x + b.y) + (b.z + b.w)) + ((c.x + c.y) + (c.z + c.w)) + ((d.x + d.y) + (d.z + d.w));
    return rsqrtf(s * (1.f / D) + EPS);
}

__device__ __forceinline__ size_t idx8(int token, int col)  { return ((size_t)((token >> 7) * 32 + (col >> 3)) * 128 + (token & 127)) * 8 + (col & 7); }
__device__ __forceinline__ size_t idx16(int token, int col) { return ((size_t)((token >> 7) * 32 + (col >> 4)) * 128 + (token & 127)) * 16 + (col & 15); }

struct Inputs {
    const float *x, *ln1_w, *w_in, *w_gate_up, *b_gate, *gla_norm_w, *conv_w, *conv_b, *cn_w, *cn_b, *w_out, *ln2_w, *wd_gate, *wd_up, *wd_down, *w_router, *we_gate, *we_up, *we_down, *final_w;
};

constexpr float W8_MUL = 64.f;
struct CvtP { const float* W; const float* scale; void* WT; int ld, col0, K, row0, kb, nb, fp8; };
__device__ __forceinline__ void cvt_load(const CvtP& P, f32x4 (&v)[16], int lane) {
    const int k0 = 64 * P.kb, n0 = 64 * P.nb, n4 = 4 * (lane & 15), kq = lane >> 4;
#pragma unroll
    for (int i = 0; i < 16; ++i) v[i] = *(const f32x4*)(P.W + (size_t)(k0 + kq + 4 * i) * P.ld + P.col0 + n0 + n4);
}
__device__ __forceinline__ void cvt_finish(const CvtP& P, f32x4 (&v)[16], LAS float* scr, int lane) {
    const int k0 = 64 * P.kb, n0 = 64 * P.nb, n4 = 4 * (lane & 15), kq = lane >> 4; const float mul = P.fp8 ? W8_MUL : 1.f;
#pragma unroll
    for (int i = 0; i < 16; ++i) v[i] *= P.scale ? P.scale[k0 + kq + 4 * i] * mul : mul;
#pragma unroll
    for (int i = 0; i < 16; ++i) { const int k = kq + 4 * i; *(LAS f32x4*)(scr + k * 64 + (n4 ^ (4 * (k >> 3)))) = v[i]; }
    asm volatile("s_waitcnt lgkmcnt(0)" ::: "memory");
    if (P.fp8) { const int c = lane & 3; unsigned char* WT = (unsigned char*)P.WT;
#pragma unroll
        for (int j = 0; j < 4; ++j) { const int n = (lane >> 2) + 16 * j; unsigned w[4];
#pragma unroll
            for (int q = 0; q < 4; ++q) { float x[4];
#pragma unroll
                for (int r = 0; r < 4; ++r) { const int k = 16 * c + 4 * q + r; x[r] = scr[k * 64 + (n ^ (4 * (k >> 3)))]; }
                int t = 0; t = __builtin_amdgcn_cvt_pk_fp8_f32(x[0], x[1], t, false); t = __builtin_amdgcn_cvt_pk_fp8_f32(x[2], x[3], t, true); w[q] = (unsigned)t; }
            *(v4u*)(WT + (size_t)(P.row0 + n0 + n) * P.K + k0 + 16 * c) = (v4u){w[0], w[1], w[2], w[3]}; }
    } else { const int c = lane & 7; bf16* WT = (bf16*)P.WT;
#pragma unroll
        for (int j = 0; j < 8; ++j) { const int n = (lane >> 3) + 8 * j; const LAS float* sp = scr + (8 * c) * 64 + (n ^ (4 * c));
            v4u o; o.x = pk2(sp[0 * 64], sp[1 * 64]); o.y = pk2(sp[2 * 64], sp[3 * 64]); o.z = pk2(sp[4 * 64], sp[5 * 64]); o.w = pk2(sp[6 * 64], sp[7 * 64]);
            *(v4u*)(WT + (size_t)(P.row0 + n0 + n) * P.K + k0 + 8 * c) = o; }
    }
    asm volatile("s_waitcnt lgkmcnt(0)" ::: "memory");
}
constexpr int CVT_ITEMS = (20 + 20 + 8 + 8 + 44) * 32 + 8 * 88 + 8 * 44 * 32 + 8 * 8 * 88;
__device__ __forceinline__ CvtP cvt_decode(const Inputs& I, unsigned char* ws, int it) {
    CvtP P; int job, r = it; P.fp8 = 0; P.scale = nullptr; P.K = 1024;
    if (r < 40 * 32) { job = r / (20 * 32); r -= job * 20 * 32; const int seg = r / 32, q = r % 32;
        if (seg < 12) { P.col0 = 128 * seg; P.row0 = 128 * seg; } else { const int t = (seg - 12) >> 1, hf = (seg - 12) & 1; P.col0 = (hf ? 2064 : 1552) + 128 * t; P.row0 = 1792 + 256 * t + 128 * hf; }
        P.W = I.w_in + (size_t)job * D * INC; P.ld = INC; P.WT = ws + (job ? WS_WIN1 : WS_WIN0); P.scale = I.ln1_w + job * D; P.kb = q >> 1; P.nb = q & 1; return P; }
    r -= 40 * 32;
    if (r < 16 * 32) { job = r / (8 * 32); r -= job * 8 * 32; const int seg = r / 32, q = r % 32;
        P.W = I.w_out + (size_t)job * D * D; P.ld = D; P.col0 = 128 * seg; P.row0 = 128 * seg; P.WT = ws + (job ? WS_WOUT1 : WS_WOUT0); P.kb = q >> 1; P.nb = q & 1; return P; }
    r -= 16 * 32;
    if (r < 44 * 32) { const int seg = r / 32, q = r % 32, t = seg >> 1, hf = seg & 1;
        P.W = hf ? I.wd_up : I.wd_gate; P.ld = FF; P.col0 = 128 * t; P.row0 = 256 * t + 128 * hf; P.WT = ws + WS_WDGU; P.scale = I.ln2_w; P.kb = q >> 1; P.nb = q & 1; return P; }
    r -= 44 * 32;
    if (r < 8 * 88) { const int seg = r / 88, q = r % 88;
        P.W = I.wd_down; P.ld = D; P.col0 = 128 * seg; P.row0 = 128 * seg; P.K = FF; P.WT = ws + WS_WDD; P.kb = q >> 1; P.nb = q & 1; return P; }
    r -= 8 * 88;
    if (r < 8 * 44 * 32) { const int e = r / (44 * 32); r -= e * 44 * 32; const int seg = r / 32, q = r % 32, t = seg >> 1, hf = seg & 1;
        P.W = (hf ? I.we_up : I.we_gate) + (size_t)e * D * FF; P.ld = FF; P.col0 = 128 * t; P.row0 = 256 * t + 128 * hf; P.WT = ws + WS_WMGU + (size_t)e * NGU * D; P.scale = I.ln2_w + D; P.fp8 = 1; P.kb = q >> 1; P.nb = q & 1; return P; }
    r -= 8 * 44 * 32;
    { const int e = r / (8 * 88); r -= e * 8 * 88; const int seg = r / 88, q = r % 88;
        P.W = I.we_down + (size_t)e * FF * D; P.ld = D; P.col0 = 128 * seg; P.row0 = 128 * seg; P.K = FF; P.WT = ws + WS_WMD + (size_t)e * D * FF; P.fp8 = 1; P.kb = q >> 1; P.nb = q & 1; return P; }
}
constexpr int CVT_BF16 = (20 + 20 + 8 + 8 + 44) * 32 + 8 * 88, CVT_GU_END = CVT_BF16 + 8 * 44 * 32;
__device__ __forceinline__ void cvt_range(const Inputs& I, unsigned char* ws, int it0, int stride, int end, LAS float* scr, int lane) {
    int it = it0; if (it >= end) return;
    CvtP P = cvt_decode(I, ws, it); f32x4 v[16]; cvt_load(P, v, lane);
    for (;;) { const int itn = it + stride; const bool more = itn < end;
        CvtP Pn = P; f32x4 vn[16];
        if (more) { Pn = cvt_decode(I, ws, itn); cvt_load(Pn, vn, lane); }
        cvt_finish(P, v, scr, lane);
        if (!more) break;
        P = Pn; it = itn;
#pragma unroll
        for (int i = 0; i < 16; ++i) v[i] = vn[i];
    }
}
__device__ __forceinline__ void cvt_gate_elem(const Inputs& I, unsigned char* ws, int idx) {
    const int l = idx >> 18, j = (idx >> 10) & 255, k = idx & 1023;
    const float* wr = I.w_in + (size_t)l * D * INC + (size_t)k * INC + 1536; const float* gu = I.w_gate_up + l * RANK * KEY + j;
    float s = 0.f;
#pragma unroll
    for (int r = 0; r < RANK; ++r) s += wr[r] * gu[r * KEY];
    bf16* dst = (bf16*)(ws + (l ? WS_WIN1 : WS_WIN0));
    dst[(size_t)(1536 + j) * D + k] = (bf16)f2bf(s * I.ln1_w[l * D + k]);
}
__device__ __forceinline__ void row_to_xb(const float* xrow, bf16* orow, float* ssqrow, int lane) {
    const f32x4* xr = (const f32x4*)xrow + lane; f32x4 v[4]; float s = 0.f;
#pragma unroll
    for (int j = 0; j < 4; ++j) { v[j] = xr[64 * j]; s += (v[j].x * v[j].x + v[j].y * v[j].y) + (v[j].z * v[j].z + v[j].w * v[j].w); }
    s = wave_sum(s);
    unsigned long long* o8 = (unsigned long long*)orow + lane;
#pragma unroll
    for (int j = 0; j < 4; ++j) o8[64 * j] = (unsigned long long)pk2(v[j].x, v[j].y) | ((unsigned long long)pk2(v[j].z, v[j].w) << 32);
    if (lane < 16) ssqrow[lane] = lane == 0 ? s : 0.f;
}

__device__ __forceinline__ int opaque_tid() { int t = threadIdx.x; asm volatile("" : "+v"(t)); return t; }
#ifdef PROBE_SEG
#ifndef PROBE_MULT
#define PROBE_MULT 64
#endif
#ifdef PROBE_CYC
#define PCLK() __builtin_amdgcn_s_memtime()
#else
#define PCLK() __builtin_amdgcn_s_memrealtime()
#endif
#define PSEG_B(ldsb, id) do { if (PROBE_SEG == (id) && threadIdx.x == 0) ((__attribute__((address_space(3))) unsigned long long*)((ldsb) + 131072 + 12288))[1] = PCLK(); } while (0)
#define PSEG_E(ldsb, id) do { if (PROBE_SEG == (id) && threadIdx.x == 0) { __attribute__((address_space(3))) unsigned long long* _pp = (__attribute__((address_space(3))) unsigned long long*)((ldsb) + 131072 + 12288); if (_pp[1] != 0ull) _pp[0] += PCLK() - _pp[1]; } } while (0)
#else
#define PSEG_B(ldsb, id) do { } while (0)
#define PSEG_E(ldsb, id) do { } while (0)
#endif
namespace pg8 {
#define PG8_LAS __attribute__((address_space(3)))
typedef short bf16x8 __attribute__((ext_vector_type(8)));
typedef unsigned u32x4 __attribute__((ext_vector_type(4)));
constexpr int BM = 256, BK = 64, HALF = 128, HTB = HALF * BK * 2  , STAGE_BYTES = 8 * HTB, NXCD = 8, WGM = 8;

__host__ __device__ __forceinline__ int lds_byte(int r, int c) { return r * 128 + ((((c >> 3) ^ ((r >> 1) & 7)) << 4)) + (c & 7) * 2; }
__host__ __device__ __forceinline__ void stage_rc(int b, int& R, int& C) { R = b >> 7; C = (((b >> 4) & 7) ^ ((R >> 1) & 7)) * 8; }
__host__ __device__ __forceinline__ int perm32(int rho) { const int n = rho >> 4, i = rho & 15; return 8 * (i >> 2) + 4 * n + (i & 3); }

struct Unit { int pm, pn, e, hm; };

__device__ __forceinline__ void unit_of(int wgid, int nM, int NN, int q, int r, int& pm, int& pn) {
    { const int xcd = wgid & (NXCD - 1), off = wgid >> 3; wgid = (xcd < r ? xcd * (q + 1) : r * (q + 1) + (xcd - r) * q) + off; }
    const int nig = WGM * NN, gid = wgid / nig, fm = gid * WGM, gsz = (nM - fm) < WGM ? (nM - fm) : WGM, rem = wgid - gid * nig;
    if (gsz == WGM) { pm = fm + (rem & (WGM - 1)); pn = rem >> 3; } else { pm = fm + rem % gsz; pn = rem / gsz; }
}
template <int NN, bool SPLIT = false> struct StaticOrder {
    static constexpr bool GATHER = false;
    int nM, nwg, G, c, q, r, nfull; const bf16* Bt;
    __device__ void init(int nM_, int G_, int c_, const bf16* Bt_) { nM = nM_; nwg = nM * NN; G = G_; c = c_; Bt = Bt_; q = nwg >> 3; r = nwg & 7; nfull = (SPLIT && 2 * (nwg % G) <= G) ? (nwg / G) * G : nwg; }
    __device__ __forceinline__ bool next(int i, Unit& u) const { int L = i * G + c; u.hm = -1; u.e = 0;
        if (L >= nfull) { const int j = L - nfull; if (j >= 2 * (nwg - nfull)) return false; L = nfull + (j >> 1); u.hm = j & 1; }
        unit_of(L, nM, NN, q, r, u.pm, u.pn); return true; }
    __device__ __forceinline__ const void* bt_root() const { return Bt; }
    __device__ __forceinline__ int bt_off(const Unit&) const { return 0; }
    __device__ __forceinline__ int row_src(const Unit&, int) const { return 0; }
};
template <bool GATHER_, int NN, bool SPLIT = false> struct MoeOrder {
    static constexpr bool GATHER = GATHER_;
    int nM, nwg, G, c, q, r, nfull; const char* Bt; size_t estride; const PG8_LAS int* tile_e; const int* rowinfo;
    __device__ void init(int nM_, int G_, int c_, const void* Bt_, size_t estride_, const PG8_LAS int* tile_e_, const int* rowinfo_) { nM = nM_; nwg = nM * NN; G = G_; c = c_; Bt = (const char*)Bt_; estride = estride_; tile_e = tile_e_; rowinfo = rowinfo_; q = nwg >> 3; r = nwg & 7;
        nfull = (SPLIT && 2 * (nwg % G) <= G) ? (nwg / G) * G : nwg; }
    __device__ __forceinline__ bool next(int i, Unit& u) const { int L = i * G + c; u.hm = -1;
        if (L >= nfull) { const int j = L - nfull; if (j >= 2 * (nwg - nfull)) return false; L = nfull + (j >> 1); u.hm = j & 1; }
        unit_of(L, nM, NN, q, r, u.pm, u.pn); u.e = __builtin_amdgcn_readfirstlane(tile_e[u.pm]); return true; }
    __device__ __forceinline__ const void* bt_root() const { return Bt; }
    __device__ __forceinline__ int bt_off(const Unit& u) const { return u.e * (int)estride; }
    __device__ __forceinline__ int row_src(const Unit& u, int R) const { return __hip_atomic_load(rowinfo + u.pm * BM + (u.hm > 0 ? HALF : 0) + R, __ATOMIC_RELAXED, __HIP_MEMORY_SCOPE_AGENT) & 0x3fff; }
};

typedef int v4i_ __attribute__((ext_vector_type(4)));
typedef int v8i_ __attribute__((ext_vector_type(8)));
__device__ __forceinline__ v8i_ cat8(const bf16x8 a, const bf16x8 b) { const v4i_ x = __builtin_bit_cast(v4i_, a), y = __builtin_bit_cast(v4i_, b); return __builtin_shufflevector(x, y, 0, 1, 2, 3, 4, 5, 6, 7); }
__device__ __forceinline__ unsigned cvt_pk_bf16(float lo, float hi) { unsigned r; asm volatile("v_cvt_pk_bf16_f32 %0, %1, %2" : "=v"(r) : "v"(lo), "v"(hi)); return r; }
__device__ __forceinline__ u32x4 pack8(const f32x4 a, const f32x4 b) { u32x4 w; w.x = cvt_pk_bf16(a[0], a[1]); w.y = cvt_pk_bf16(a[2], a[3]); w.z = cvt_pk_bf16(b[0], b[1]); w.w = cvt_pk_bf16(b[2], b[3]); return w; }

template <class Epi, class Sched, bool ALIGN_EPI = false, bool SP2 = false, bool FP8 = false, int SCALE_W = 0x7f7f7f7f, int SCALE_X = 0x7f7f7f7f>
__device__ __forceinline__ void gemm_phase(PG8_LAS unsigned char* lds, PG8_LAS float* tab, const void* Abase, const int K, const Sched& S, const Epi& E) {
    const int tid = opaque_tid(), wid = __builtin_amdgcn_readfirstlane(tid >> 6), lane = tid & 63, wr = wid >> 2, wc = wid & 3, fr = lane & 15, fq = lane >> 4;
    const int rowb = FP8 ? K : 2 * K;
    const int nt = rowb / 128;
    Unit cur, nxt; int ui = 0;
    if (!S.next(0, cur)) return;
    bool has_next = S.next(1, nxt);
    E.prep_store(E.prep_load(cur, tid), tab, 0, tid); __builtin_amdgcn_sched_barrier(0);
    const int kstep = BK * 2;
    const int hstep = HALF * rowb;
    const int tstep = 2 * hstep;
    unsigned voffB[2], vA[2][2], vN[2][2];
#pragma unroll
    for (int i = 0; i < 2; ++i) { int R, C; stage_rc(tid * 16 + i * 8192, R, C); const int Rb = Epi::PERM ? ((R & ~31) + perm32(R & 31)) : R;
        voffB[i] = (unsigned)(Rb * rowb + C * 2);
#pragma unroll
        for (int h = 0; h < 2; ++h) { vA[h][i] = (unsigned)(R * rowb + C * 2); vN[h][i] = vA[h][i]; } }
    const int hA = Sched::GATHER ? 0 : hstep;
    const unsigned ldsw = (unsigned)wid * 1024u;
    const int aoff0 = lds_byte(wr * 64 + fr, fq * 8), aoff1 = lds_byte(wr * 64 + fr, 32 + fq * 8), boff0 = lds_byte(wc * 32 + fr, fq * 8), boff1 = lds_byte(wc * 32 + fr, 32 + fq * 8);
#define PG8_SA(b, h) (((b) * 2 + (h)) * HTB)
#define PG8_SB(b, h) ((4 + (b) * 2 + (h)) * HTB)
#define PG8_STAGE(bufoff, rsrc, soff, voff) do { _Pragma("unroll") for (int _i = 0; _i < 2; ++_i) \
        __builtin_amdgcn_raw_ptr_buffer_load_lds(rsrc, (PG8_LAS void*)(lds + (bufoff) + ldsw + _i * 8192), 16, (int)(voff)[_i], (int)(soff), 0, 0); } while (0)
#define PG8_LD8(p0, p1) __builtin_shufflevector(*(const PG8_LAS v4i_*)(p0), *(const PG8_LAS v4i_*)(p1), 0, 1, 2, 3, 4, 5, 6, 7)
#define PG8_LDA(dst, b, h) do { if constexpr (FP8) { _Pragma("unroll") for (int m = 0; m < 4; ++m) dst##8[m] = PG8_LD8(lds + PG8_SA(b, h) + aoff0 + m * 2048, lds + PG8_SA(b, h) + aoff1 + m * 2048); } else { \
        _Pragma("unroll") for (int m = 0; m < 4; ++m) { dst[m][0] = *(const PG8_LAS bf16x8*)(lds + PG8_SA(b, h) + aoff0 + m * 2048); dst[m][1] = *(const PG8_LAS bf16x8*)(lds + PG8_SA(b, h) + aoff1 + m * 2048); } } } while (0)
#define PG8_LDB(dst, b, h) do { if constexpr (FP8) { _Pragma("unroll") for (int n = 0; n < 2; ++n) dst##8[n] = PG8_LD8(lds + PG8_SB(b, h) + boff0 + n * 2048, lds + PG8_SB(b, h) + boff1 + n * 2048); } else { \
        _Pragma("unroll") for (int n = 0; n < 2; ++n) { dst[n][0] = *(const PG8_LAS bf16x8*)(lds + PG8_SB(b, h) + boff0 + n * 2048); dst[n][1] = *(const PG8_LAS bf16x8*)(lds + PG8_SB(b, h) + boff1 + n * 2048); } } } while (0)
#define PG8_MMA(ai, bj, At, Bt) do { __builtin_amdgcn_s_setprio(1); if constexpr (FP8) { _Pragma("unroll") for (int m = 0; m < 4; ++m) _Pragma("unroll") for (int n = 0; n < 2; ++n) \
        asm volatile("v_mfma_scale_f32_16x16x128_f8f6f4 %0, %1, %2, %0, %3, %4 op_sel_hi:[0,0,0]" : "+v"(acc[ai][bj][m][n]) : "v"(Bt##8[n]), "v"(At##8[m]), "v"(scw), "v"(scx)); } else { \
        _Pragma("unroll") for (int m = 0; m < 4; ++m) _Pragma("unroll") for (int n = 0; n < 2; ++n) _Pragma("unroll") for (int k = 0; k < 2; ++k) \
        acc[ai][bj][m][n] = __builtin_amdgcn_mfma_f32_16x16x32_bf16(Bt[n][k], At[m][k], acc[ai][bj][m][n], 0, 0, 0); } __builtin_amdgcn_s_setprio(0); } while (0)
#define PG8_WAIT_V(n) asm volatile("s_waitcnt vmcnt(" #n ")" ::: "memory")
#define PG8_WAIT_L(n) asm volatile("s_waitcnt lgkmcnt(" #n ")" ::: "memory")
#define PG8_BAR __builtin_amdgcn_s_barrier()
#define PG8_SCHED __builtin_amdgcn_sched_barrier(0)
    f32x4 acc[2][2][4][2];
#pragma unroll
    for (int a = 0; a < 2; ++a)
#pragma unroll
        for (int b = 0; b < 2; ++b)
#pragma unroll
            for (int m = 0; m < 4; ++m)
#pragma unroll
                for (int n = 0; n < 2; ++n) acc[a][b][m][n] = (f32x4){0.f, 0.f, 0.f, 0.f};
    int scw = SCALE_W, scx = SCALE_X; asm volatile("" : "+v"(scw), "+v"(scx));
    bf16x8 At[4][2], B0[2][2], B1[2][2]; v8i_ At8[4], B08[2], B18[2];
    const __amdgpu_buffer_rsrc_t rA = __builtin_amdgcn_make_buffer_rsrc((void*)Abase, 0, 0xffffffff, 0x00020000), rB = __builtin_amdgcn_make_buffer_rsrc((void*)S.bt_root(), 0, 0xffffffff, 0x00020000);
    int cA, cB = S.bt_off(cur) + cur.pn * tstep;
    if constexpr (Sched::GATHER) {
        cA = 0;
#pragma unroll
        for (int h = 0; h < 2; ++h)
#pragma unroll
            for (int i = 0; i < 2; ++i) { int R, C; stage_rc(tid * 16 + i * 8192, R, C); vA[h][i] = (unsigned)(S.row_src(cur, h * HALF + R) * rowb + C * 2); vN[h][i] = has_next ? (unsigned)(S.row_src(nxt, h * HALF + R) * rowb + C * 2) : vA[h][i]; }
    } else cA = cur.pm * tstep + (cur.hm > 0 ? hstep : 0);
    asm volatile("" : "+v"(voffB[0]), "+v"(voffB[1]), "+v"(vA[0][0]), "+v"(vA[0][1]), "+v"(vA[1][0]), "+v"(vA[1][1]));
    if constexpr (SP2) {
        PG8_STAGE(PG8_SB(0, 0), rB, cB, voffB); PG8_STAGE(PG8_SB(0, 1), rB, cB + hstep, voffB); PG8_STAGE(PG8_SA(0, 0), rA, cA, vA[0]); PG8_STAGE(PG8_SA(0, 1), rA, cA + hA, vA[1]);
        if (wr == 1) PG8_BAR;
        PG8_WAIT_V(2); PG8_BAR;
        PG8_STAGE(PG8_SB(1, 0), rB, cB + kstep, voffB); PG8_STAGE(PG8_SA(1, 0), rA, cA + kstep, vA[0]); PG8_STAGE(PG8_SB(1, 1), rB, cB + hstep + kstep, voffB);
        PG8_WAIT_V(6); PG8_BAR;
    } else {
        PG8_STAGE(PG8_SB(0, 0), rB, cB, voffB); PG8_STAGE(PG8_SA(0, 0), rA, cA, vA[0]); PG8_STAGE(PG8_SB(0, 1), rB, cB + hstep, voffB); PG8_STAGE(PG8_SA(0, 1), rA, cA + hA, vA[1]);
        if (wr == 1) PG8_BAR;
        PG8_WAIT_V(4); PG8_BAR;
        PG8_STAGE(PG8_SB(1, 0), rB, cB + kstep, voffB); PG8_STAGE(PG8_SA(1, 0), rA, cA + kstep, vA[0]); PG8_STAGE(PG8_SB(1, 1), rB, cB + hstep + kstep, voffB);
        PG8_WAIT_V(6); PG8_BAR;
    }
    for (;;) {
        int nA; const int nB = has_next ? S.bt_off(nxt) + nxt.pn * tstep : cB;
        if constexpr (Sched::GATHER) nA = cA; else nA = has_next ? nxt.pm * tstep + (nxt.hm > 0 ? hstep : 0) : cA;
        const bool whole = cur.hm < 0;
        if constexpr (FP8 && Sched::GATHER) { PSEG_E(lds, 12); PSEG_B(lds, 10); }
#pragma clang loop unroll(disable)
        for (int t = 0; t < nt; t += 2) {
            const bool last = (t == nt - 2);
            const int a1 = cA + (t + 1) * kstep;
            const int a2 = last ? nA : cA + (t + 2) * kstep; const int b2 = last ? nB : cB + (t + 2) * kstep;
            const int a3 = a2 + kstep; const int b3 = b2 + kstep;
            unsigned v2[2][2];
#pragma unroll
            for (int h = 0; h < 2; ++h)
#pragma unroll
                for (int i = 0; i < 2; ++i) v2[h][i] = (Sched::GATHER && last) ? vN[h][i] : vA[h][i];
            if constexpr (SP2) {
            PG8_LDB(B0, 0, 0); PG8_LDB(B1, 0, 1); PG8_SCHED; PG8_LDA(At, 0, 0); PG8_STAGE(PG8_SA(1, 1), rA, a1 + hA, vA[1]);
            PG8_WAIT_V(8); PG8_WAIT_L(0); PG8_BAR; PG8_MMA(0, 0, At, B0); PG8_MMA(0, 1, At, B1); PG8_BAR; PG8_SCHED;
            PG8_LDA(At, 0, 1); PG8_STAGE(PG8_SB(0, 0), rB, b2, voffB); PG8_STAGE(PG8_SB(0, 1), rB, b2 + hstep, voffB); PG8_STAGE(PG8_SA(0, 0), rA, a2, v2[0]);
            PG8_WAIT_V(8); PG8_WAIT_L(0); PG8_BAR; if (whole) { PG8_MMA(1, 0, At, B0); PG8_MMA(1, 1, At, B1); } PG8_BAR; PG8_SCHED;
            PG8_LDB(B0, 1, 0); PG8_LDB(B1, 1, 1); PG8_SCHED; PG8_LDA(At, 1, 0); PG8_STAGE(PG8_SA(0, 1), rA, a2 + hA, v2[1]);
            PG8_WAIT_V(8); PG8_WAIT_L(0); PG8_BAR; PG8_MMA(0, 0, At, B0); PG8_MMA(0, 1, At, B1); PG8_BAR; PG8_SCHED;
            PG8_LDA(At, 1, 1); PG8_STAGE(PG8_SB(1, 0), rB, b3, voffB); PG8_STAGE(PG8_SB(1, 1), rB, b3 + hstep, voffB); PG8_STAGE(PG8_SA(1, 0), rA, a3, v2[0]);
            PG8_WAIT_V(8); PG8_WAIT_L(0); PG8_BAR; if (whole) { PG8_MMA(1, 0, At, B0); PG8_MMA(1, 1, At, B1); } PG8_BAR; PG8_SCHED;
            } else {
            PG8_LDB(B0, 0, 0); PG8_SCHED; PG8_LDA(At, 0, 0); PG8_STAGE(PG8_SA(1, 1), rA, a1 + hA, vA[1]);
            PG8_WAIT_L(8); PG8_BAR; PG8_WAIT_L(0); PG8_MMA(0, 0, At, B0); PG8_BAR; PG8_SCHED;
            PG8_LDB(B1, 0, 1); PG8_STAGE(PG8_SB(0, 0), rB, b2, voffB);
            PG8_BAR; PG8_WAIT_L(0); PG8_MMA(0, 1, At, B1); PG8_BAR;
            PG8_LDA(At, 0, 1); PG8_STAGE(PG8_SA(0, 0), rA, a2, v2[0]);
            PG8_BAR; PG8_WAIT_L(0); PG8_MMA(1, 0, At, B0); PG8_BAR; PG8_SCHED;
            PG8_STAGE(PG8_SB(0, 1), rB, b2 + hstep, voffB);
            PG8_WAIT_V(6); PG8_BAR; PG8_MMA(1, 1, At, B1); PG8_BAR;
            PG8_LDB(B0, 1, 0); PG8_SCHED; PG8_LDA(At, 1, 0); PG8_STAGE(PG8_SA(0, 1), rA, a2 + hA, v2[1]);
            PG8_WAIT_L(8); PG8_BAR; PG8_WAIT_L(0); PG8_MMA(0, 0, At, B0); PG8_BAR; PG8_SCHED;
            PG8_LDB(B1, 1, 1); PG8_STAGE(PG8_SB(1, 0), rB, b3, voffB);
            PG8_BAR; PG8_WAIT_L(0); PG8_MMA(0, 1, At, B1); PG8_BAR;
            PG8_LDA(At, 1, 1); PG8_STAGE(PG8_SA(1, 0), rA, a3, v2[0]);
            PG8_BAR; PG8_WAIT_L(0); PG8_MMA(1, 0, At, B0); PG8_BAR; PG8_SCHED;
            PG8_STAGE(PG8_SB(1, 1), rB, b3 + hstep, voffB);
            PG8_WAIT_V(6); PG8_BAR; PG8_MMA(1, 1, At, B1); PG8_BAR;
            }
        }
        if constexpr (FP8 && Sched::GATHER) { PSEG_E(lds, 10); PSEG_B(lds, 11); }
        if constexpr (ALIGN_EPI) { if (wr == 0) PG8_BAR; }
        if constexpr (FP8) asm volatile("s_nop 15\n\ts_nop 15" ::: "memory");
        const int tid2 = opaque_tid(), lane2 = tid2 & 63;
        typename Epi::Prep pr; if (has_next) pr = E.prep_load(nxt, tid2);
        Unit nn; nn.pm = nn.pn = nn.e = 0; nn.hm = -1; const bool has2 = has_next && S.next(ui + 2, nn);
        unsigned tn[2][2];
        if constexpr (Sched::GATHER) {
#pragma unroll
            for (int h = 0; h < 2; ++h)
#pragma unroll
                for (int i = 0; i < 2; ++i) { int R, C; stage_rc(tid2 * 16 + i * 8192, R, C); tn[h][i] = has2 ? (unsigned)(S.row_src(nn, h * HALF + R) * rowb + C * 2) : 0u; }
        }
        E(acc, cur, tab + (ui & 1) * 512, wr, wc, lane2 & 15, lane2 >> 4);
        if constexpr (FP8 && Sched::GATHER) { PSEG_E(lds, 11); PSEG_B(lds, 12); }
        if (!has_next) break;
        E.prep_store(pr, tab, (ui + 1) & 1, tid2); __builtin_amdgcn_sched_barrier(0);
#pragma unroll
        for (int a = 0; a < 2; ++a)
#pragma unroll
            for (int b = 0; b < 2; ++b)
#pragma unroll
                for (int m = 0; m < 4; ++m)
#pragma unroll
                    for (int n = 0; n < 2; ++n) acc[a][b][m][n] = (f32x4){0.f, 0.f, 0.f, 0.f};
        if constexpr (Sched::GATHER) {
#pragma unroll
            for (int h = 0; h < 2; ++h)
#pragma unroll
                for (int i = 0; i < 2; ++i) { const unsigned tnew = has2 ? tn[h][i] : vN[h][i]; vA[h][i] = vN[h][i]; vN[h][i] = tnew; }
        }
        cur = nxt; nxt = nn; has_next = has2; cA = nA; cB = nB; ++ui;
        if constexpr (ALIGN_EPI) { if (wr == 1) PG8_BAR; }
    }
    PG8_WAIT_V(0);
    if constexpr (!ALIGN_EPI) { if (wr == 0) PG8_BAR; }
    PG8_BAR;
#undef PG8_SA
#undef PG8_SB
#undef PG8_STAGE
#undef PG8_LDA
#undef PG8_LDB
#undef PG8_MMA
#undef PG8_WAIT_V
#undef PG8_WAIT_L
#undef PG8_BAR
#undef PG8_SCHED
}
}
namespace pg8 {
__device__ __forceinline__ float silu_fast(float x) { return x * __builtin_amdgcn_rcpf(1.f + __expf(-x)); }
__device__ __forceinline__ float sigm_fast(float x) { return __builtin_amdgcn_rcpf(1.f + __expf(-x)); }
__device__ __forceinline__ f32x4 silu4(const f32x4 v) { f32x4 o; o[0] = silu_fast(v[0]); o[1] = silu_fast(v[1]); o[2] = silu_fast(v[2]); o[3] = silu_fast(v[3]); return o; }
__device__ __forceinline__ f32x4 sigm4(const f32x4 v) { f32x4 o; o[0] = sigm_fast(v[0]); o[1] = sigm_fast(v[1]); o[2] = sigm_fast(v[2]); o[3] = sigm_fast(v[3]); return o; }
__device__ __forceinline__ unsigned long long pack8_fp8(const f32x4 a, const f32x4 b) { int lo = 0, hi = 0; lo = __builtin_amdgcn_cvt_pk_fp8_f32(a[0], a[1], lo, false); lo = __builtin_amdgcn_cvt_pk_fp8_f32(a[2], a[3], lo, true);
    hi = __builtin_amdgcn_cvt_pk_fp8_f32(b[0], b[1], hi, false); hi = __builtin_amdgcn_cvt_pk_fp8_f32(b[2], b[3], hi, true); return (unsigned long long)(unsigned)lo | ((unsigned long long)(unsigned)hi << 32); }
__device__ __forceinline__ float logsig_fast(float x) { return fminf(x, 0.f) - __logf(1.f + __expf(-fabsf(x))); }
struct PrepNone { };
struct Prep2 { float a, b; };
struct EpiIn {
    static constexpr bool PERM = true; typedef Prep2 Prep;
    const float* ssq; const float* b_gate; bf16 *QS, *KB, *VB, *SG, *UB; float* LA;
    __device__ __forceinline__ Prep prep_load(const Unit& u, int tid) const { Prep p; p.b = 0.f; p.a = row_rstd(ssq, u.pm * BM + (u.hm > 0 ? HALF : 0) + (tid & 255)); return p; }
    __device__ __forceinline__ void prep_store(const Prep& p, PG8_LAS float* tab, int par, int tid) const { tab[par * 512 + (tid & 255)] = p.a; }
    __device__ __forceinline__ void operator()(const f32x4 (&acc)[2][2][4][2], const Unit& u, const PG8_LAS float* tb, int wr, int wc, int fr, int fq) const {
        const int tile = u.pn, cin = wc * 32 + 8 * fq, rb0 = u.pm * BM + (u.hm > 0 ? HALF : 0);
        f32x4 bg[2][2];
        if (tile == 6) {
#pragma unroll
            for (int bj = 0; bj < 2; ++bj)
#pragma unroll
                for (int n = 0; n < 2; ++n) bg[bj][n] = *(const f32x4*)(b_gate + bj * 128 + cin + 4 * n);
        }
#pragma unroll
        for (int ai = 0; ai < 2; ++ai) if (ai == 0 || u.hm < 0)
#pragma unroll
            for (int m = 0; m < 4; ++m) {
                const int lr = ai * HALF + wr * 64 + m * 16 + fr, row = rb0 + lr; const float r = tb[lr];
                const f32x4 l0 = acc[ai][0][m][0] * r, l1 = acc[ai][0][m][1] * r, h0 = acc[ai][1][m][0] * r, h1 = acc[ai][1][m][1] * r;
                if (tile == 0) { *(u32x4*)(QS + idx8(row, cin)) = pack8(l0 * 0.125f, l1 * 0.125f); *(u32x4*)(QS + idx8(row, 128 + cin)) = pack8(h0 * 0.125f, h1 * 0.125f); }
                else if (tile == 1) { *(u32x4*)(KB + idx8(row, cin)) = pack8(l0, l1); *(u32x4*)(KB + idx8(row, 128 + cin)) = pack8(h0, h1); }
                else if (tile < 4) { const int c = (tile - 2) * 256 + cin; *(u32x4*)(VB + idx16(row, c)) = pack8(l0, l1); *(u32x4*)(VB + idx16(row, c + 128)) = pack8(h0, h1); }
                else if (tile < 6) { const int c = (tile - 4) * 256 + cin; *(u32x4*)(SG + idx16(row, c)) = pack8(silu4(l0), silu4(l1)); *(u32x4*)(SG + idx16(row, c + 128)) = pack8(silu4(h0), silu4(h1)); }
                else if (tile == 6) { float* p = LA + idx8(row, cin); float* ph = LA + idx8(row, 128 + cin); f32x4 o;
#pragma unroll
                    for (int j = 0; j < 4; ++j) o[j] = logsig_fast(l0[j] + bg[0][0][j]) * 0.0625f; *(f32x4*)p = o;
#pragma unroll
                    for (int j = 0; j < 4; ++j) o[j] = logsig_fast(l1[j] + bg[0][1][j]) * 0.0625f; *(f32x4*)(p + 4) = o;
#pragma unroll
                    for (int j = 0; j < 4; ++j) o[j] = logsig_fast(h0[j] + bg[1][0][j]) * 0.0625f; *(f32x4*)ph = o;
#pragma unroll
                    for (int j = 0; j < 4; ++j) o[j] = logsig_fast(h1[j] + bg[1][1][j]) * 0.0625f; *(f32x4*)(ph + 4) = o; }
                else { bf16* p = UB + (size_t)row * CCH + (tile - 7) * 128 + cin; *(u32x4*)p = pack8(l0 * sigm4(h0), l1 * sigm4(h1)); }
            }
    }
};
struct EpiRes {
    static constexpr bool PERM = true; typedef PrepNone Prep;
    bf16* XB; float* SSQ; unsigned char* X8;
    __device__ __forceinline__ Prep prep_load(const Unit&, int) const { return Prep(); }
    __device__ __forceinline__ void prep_store(const Prep&, PG8_LAS float*, int, int) const {}
    __device__ __forceinline__ void operator()(const f32x4 (&acc)[2][2][4][2], const Unit& u, const PG8_LAS float*, int wr, int wc, int fr, int fq) const {
        const int cin = wc * 32 + 8 * fq, rb0 = u.pm * BM + (u.hm > 0 ? HALF : 0); (void)rb0;
#pragma unroll
        for (int ai = 0; ai < 2; ++ai) if (ai == 0 || u.hm < 0) {
            u32x4 rv[4][2];
#pragma unroll
            for (int m = 0; m < 4; ++m) { const size_t o = (size_t)(rb0 + ai * HALF + wr * 64 + m * 16 + fr) * D + u.pn * BM + cin;
#pragma unroll
                for (int bj = 0; bj < 2; ++bj) rv[m][bj] = *(const u32x4*)(XB + o + bj * HALF); }
#pragma unroll
            for (int m = 0; m < 4; ++m) {
                const int row = rb0 + ai * HALF + wr * 64 + m * 16 + fr; const size_t o = (size_t)row * D + u.pn * BM + cin; float ss = 0.f;
#pragma unroll
                for (int bj = 0; bj < 2; ++bj) { const u32x4 r = rv[m][bj];
                    const f32x4 x0 = (f32x4){__uint_as_float(r.x << 16), __uint_as_float(r.x & 0xffff0000u), __uint_as_float(r.y << 16), __uint_as_float(r.y & 0xffff0000u)} + acc[ai][bj][m][0];
                    const f32x4 x1 = (f32x4){__uint_as_float(r.z << 16), __uint_as_float(r.z & 0xffff0000u), __uint_as_float(r.w << 16), __uint_as_float(r.w & 0xffff0000u)} + acc[ai][bj][m][1];
                    *(u32x4*)(XB + o + bj * HALF) = pack8(x0, x1);
                    if (X8) *(unsigned long long*)(X8 + o + bj * HALF) = pack8_fp8(x0, x1);
                    ss += (x0[0] * x0[0] + x0[1] * x0[1]) + (x0[2] * x0[2] + x0[3] * x0[3]) + (x1[0] * x1[0] + x1[1] * x1[1]) + (x1[2] * x1[2] + x1[3] * x1[3]); }
                ss += __shfl_xor(ss, 16); ss += __shfl_xor(ss, 32);
                if (fq == 0) SSQ[(size_t)row * 16 + u.pn * 4 + wc] = ss;
            }
            asm volatile("" ::: "memory");
        }
    }
};
struct EpiUp {
    static constexpr bool PERM = true; typedef Prep2 Prep;
    const float* ssq; bf16* ACT;
    __device__ __forceinline__ Prep prep_load(const Unit& u, int tid) const { Prep p; p.b = 0.f; p.a = row_rstd(ssq, u.pm * BM + (u.hm > 0 ? HALF : 0) + (tid & 255)); return p; }
    __device__ __forceinline__ void prep_store(const Prep& p, PG8_LAS float* tab, int par, int tid) const { tab[par * 512 + (tid & 255)] = p.a; }
    __device__ __forceinline__ void operator()(const f32x4 (&acc)[2][2][4][2], const Unit& u, const PG8_LAS float* tb, int wr, int wc, int fr, int fq) const {
        const int cin = wc * 32 + 8 * fq, rb0 = u.pm * BM + (u.hm > 0 ? HALF : 0); (void)rb0;
#pragma unroll
        for (int ai = 0; ai < 2; ++ai) if (ai == 0 || u.hm < 0)
#pragma unroll
            for (int m = 0; m < 4; ++m) {
                const int lr = ai * HALF + wr * 64 + m * 16 + fr, row = rb0 + lr; const float r = tb[lr];
                const f32x4 g0 = silu4(acc[ai][0][m][0] * r), g1 = silu4(acc[ai][0][m][1] * r);
                *(u32x4*)(ACT + (size_t)row * FF + u.pn * 128 + cin) = pack8(g0 * (acc[ai][1][m][0] * r), g1 * (acc[ai][1][m][1] * r));
            }
    }
};
struct EpiUpMoe {
    static constexpr bool PERM = true; typedef Prep2 Prep;
    const float* ssq; const int* rowinfo; const float* rowg; unsigned char* ACT;
    __device__ __forceinline__ Prep prep_load(const Unit& u, int tid) const { Prep p; p.a = 0.f; p.b = 0.f;
        { const int row = u.pm * BM + (u.hm > 0 ? HALF : 0) + (tid & 255); const int tok = rowinfo[row] & 0x3fff; p.a = row_rstd(ssq, tok); p.b = rowg[row] * p.a * 16.f; } return p; }
    __device__ __forceinline__ void prep_store(const Prep& p, PG8_LAS float* tab, int par, int tid) const { tab[par * 512 + (tid & 255)] = p.a; tab[par * 512 + 256 + (tid & 255)] = p.b; }
    __device__ __forceinline__ void operator()(const f32x4 (&acc)[2][2][4][2], const Unit& u, const PG8_LAS float* tb, int wr, int wc, int fr, int fq) const {
        const int cin = wc * 32 + 8 * fq, rb0 = u.pm * BM + (u.hm > 0 ? HALF : 0); (void)rb0;
#pragma unroll
        for (int ai = 0; ai < 2; ++ai) if (ai == 0 || u.hm < 0)
#pragma unroll
            for (int m = 0; m < 4; ++m) {
                const int lr = ai * HALF + wr * 64 + m * 16 + fr, row = rb0 + lr; const float r = tb[lr], gw = tb[256 + lr];
                const f32x4 g0 = silu4(acc[ai][0][m][0] * r), g1 = silu4(acc[ai][0][m][1] * r);
                *(unsigned long long*)(ACT + (size_t)row * FF + u.pn * 128 + cin) = pack8_fp8(g0 * (acc[ai][1][m][0] * gw), g1 * (acc[ai][1][m][1] * gw));
            }
    }
};
struct EpiDownMoe {
    static constexpr bool PERM = true; typedef Prep2 Prep;
    const int* rowinfo; bf16* YY;
    __device__ __forceinline__ Prep prep_load(const Unit& u, int tid) const { Prep p; p.b = 0.f; p.a = __int_as_float(rowinfo[u.pm * BM + (u.hm > 0 ? HALF : 0) + (tid & 255)]); return p; }
    __device__ __forceinline__ void prep_store(const Prep& p, PG8_LAS float* tab, int par, int tid) const { tab[par * 512 + (tid & 255)] = p.a; }
    __device__ __forceinline__ void operator()(const f32x4 (&acc)[2][2][4][2], const Unit& u, const PG8_LAS float* tb, int wr, int wc, int fr, int fq) const {
        const int cin = wc * 32 + 8 * fq, rb0 = u.pm * BM + (u.hm > 0 ? HALF : 0); (void)rb0;
#pragma unroll
        for (int ai = 0; ai < 2; ++ai) if (ai == 0 || u.hm < 0)
#pragma unroll
            for (int m = 0; m < 4; ++m) {
                const int lr = ai * HALF + wr * 64 + m * 16 + fr; const int info = __float_as_int(tb[lr]);
                if (info & 0x8000) { bf16* p = YY + (size_t)(info & 0x3fff) * 2048 + ((info >> 14) & 1) * 1024 + u.pn * BM + cin;
#pragma unroll
                    for (int bj = 0; bj < 2; ++bj) *(u32x4*)(p + bj * HALF) = pack8(acc[ai][bj][m][0], acc[ai][bj][m][1]); }
            }
    }
};
}

#define XB_TMO      128
#define XB_XCNT(j)  (256  + 64 * (j))
#define XB_XSUB(j)  (1280 + 64 * (j))
#define XB_XGEN(j)  (2304 + 64 * (j))
#define XB_TOP      3328
#define XB_TOPGEN   3392
#define XCD_BAR_WORDS 3456
#define XB_SPIN_CAP (1u << 18)
__device__ __forceinline__ unsigned xb_ld(unsigned* p)              { return __hip_atomic_load(p, __ATOMIC_RELAXED, __HIP_MEMORY_SCOPE_AGENT); }
__device__ __forceinline__ unsigned xb_add(unsigned* p, unsigned v) { return __hip_atomic_fetch_add(p, v, __ATOMIC_RELAXED, __HIP_MEMORY_SCOPE_AGENT); }
__device__ __forceinline__ unsigned xb_xcc_id() { return (unsigned)__builtin_amdgcn_s_getreg((3 << 11) | 20) & 0xFu; }
#define XB_SPIN(cond, bar) do { unsigned _sp = 0; while (cond) { __builtin_amdgcn_s_sleep(1); \
    if ((++_sp & 255u) == 0u) { if (xb_ld(&(bar)[XB_TMO])) break; if (_sp > XB_SPIN_CAP) { atomicAdd(&(bar)[XB_TMO], 1u); break; } } } } while (0)
struct XcdBarrier { unsigned* bar; unsigned x; volatile LAS unsigned* st; };
__device__ __forceinline__ XcdBarrier xcd_barrier_post(unsigned* bar, volatile LAS unsigned* st) {
    XcdBarrier b; b.bar = bar; b.x = xb_xcc_id(); b.st = st;
    if (threadIdx.x == 0) (void)xb_add(&bar[XB_XCNT(b.x)], 1u);
    return b;
}
__device__ __forceinline__ void xcd_barrier_complete(unsigned* bar, unsigned x, unsigned& nloc, unsigned& nx) {
    const unsigned G = gridDim.x * gridDim.y * gridDim.z;
    unsigned sum, cnt, mine, sp = 0u;
    for (;;) {
        sum = 0u; cnt = 0u; mine = 0u;
#pragma unroll
        for (unsigned j = 0; j < 16; ++j) { const unsigned c = xb_ld(&bar[XB_XCNT(j)]); sum += c; cnt += (c > 0u) ? 1u : 0u; mine = (j == x) ? c : mine; }
        if (sum == G) break;
        __builtin_amdgcn_s_sleep(1);
        if ((++sp & 255u) == 0u) { if (xb_ld(&bar[XB_TMO])) break; if (sp > XB_SPIN_CAP) { atomicAdd(&bar[XB_TMO], 1u); break; } }
    }
    nloc = mine > 0u ? mine : 1u; nx = cnt > 0u ? cnt : 1u;
}
__device__ __forceinline__ void xcd_barrier(const XcdBarrier& b) {
    asm volatile("s_waitcnt vmcnt(0)" ::: "memory");
    __syncthreads();
    if (threadIdx.x == 0) {
        unsigned* bar = b.bar;
        __builtin_amdgcn_s_waitcnt(0);
        unsigned nloc = b.st[0], nx = b.st[1];
        if (nloc == 0u) { xcd_barrier_complete(bar, b.x, nloc, nx); b.st[0] = nloc; b.st[1] = nx; }
        const unsigned old = xb_add(&bar[XB_XSUB(b.x)], 1u);
        const unsigned gen = old / nloc;
        if (old + 1u == (gen + 1u) * nloc) {
            __builtin_amdgcn_fence(__ATOMIC_RELEASE, "agent");
            asm volatile("s_waitcnt vmcnt(0)" ::: "memory");
            const unsigned og = xb_add(&bar[XB_TOP], 1u);
            const unsigned tg = og / nx;
            if (og + 1u == (tg + 1u) * nx) xb_add(&bar[XB_TOPGEN], 1u);
            else XB_SPIN(xb_ld(&bar[XB_TOPGEN]) == tg, bar);
            __builtin_amdgcn_fence(__ATOMIC_ACQUIRE, "agent");
            xb_add(&bar[XB_XGEN(b.x)], 1u);
            asm volatile("s_waitcnt vmcnt(0)" ::: "memory");
        } else {
            XB_SPIN(xb_ld(&bar[XB_XGEN(b.x)]) == gen, bar);
            __builtin_amdgcn_fence(__ATOMIC_ACQUIRE, "agent");
            asm volatile("s_waitcnt vmcnt(0)" ::: "memory");
        }
    }
    __syncthreads();
}

constexpr int NWAVES = 8, NTHR = 512;
constexpr int RING_BYTES = 131072, MISC_OFF = RING_BYTES, LDS_BYTES = 147456;
constexpr size_t MI_CNT = 1024 * 1024, MI_ROWINFO = 1040 * 1024, MI_ROWG = 1184 * 1024, MI_TILEE = 1328 * 1024;
constexpr int MAXTILES = 136;
constexpr size_t WS_ACTM = WS_WIN0;
constexpr size_t WS_Y1 = WS_XB;
static_assert(WS_ACTM + (size_t)MAXTILES * 256 * FF * 2 <= WS_END, "ACTM fits");

typedef short bf16x8 __attribute__((ext_vector_type(8)));

__device__ __forceinline__ void lds_barrier() { asm volatile("s_waitcnt lgkmcnt(0)" ::: "memory"); __builtin_amdgcn_s_barrier(); asm volatile("" ::: "memory"); }

struct GlaIn { f32x4 la[2][2]; v4u q[2], k[2], v[2][2]; };
__device__ __forceinline__ void gla_chunk_load(int g, GlaIn& in, const bf16* QSg, const bf16* KBg, const bf16* VBg, const float* LAg) {
    const int tid = opaque_tid(), lane = tid & 63, w = tid >> 6; const int bh = g >> 5, n = g & 31, b = bh >> 2, h = bh & 3; const size_t row0 = (size_t)b * T + n * CHUNK;
    const int tok = (int)row0 + 2 * lane;
    const f32x4* lp = (const f32x4*)(LAg + idx8(tok, h * 64 + 8 * w)); const v4u* qp = (const v4u*)(QSg + idx8(tok, h * 64 + 8 * w)); const v4u* kp = (const v4u*)(KBg + idx8(tok, h * 64 + 8 * w)); const v4u* vp = (const v4u*)(VBg + idx16(tok, h * 128 + 16 * w));
#pragma unroll
    for (int rr = 0; rr < 2; ++rr) { in.la[rr][0] = lp[2 * rr]; in.la[rr][1] = lp[2 * rr + 1]; in.q[rr] = qp[rr]; in.k[rr] = kp[rr]; in.v[rr][0] = vp[2 * rr]; in.v[rr][1] = vp[2 * rr + 1]; }
}
__device__ __forceinline__ float bf_lo(unsigned w) { return __uint_as_float(w << 16); }
__device__ __forceinline__ float bf_hi(unsigned w) { return __uint_as_float(w & 0xffff0000u); }
__device__ __forceinline__ void gla_chunk_unit(int g, const GlaIn& in, LAS unsigned char* lds, bf16* QTg, bf16* OIg, float* DSg, float* DECg) {
    const int tid = opaque_tid(), lane = tid & 63, wid = __builtin_amdgcn_readfirstlane(tid >> 6);
    const int bh = g >> 5, n = g & 31, b = bh >> 2, h = bh & 3; const size_t row0 = (size_t)b * T + n * CHUNK;
    LAS bf16* QTl = (LAS bf16*)lds; LAS bf16* KTl = (LAS bf16*)(lds + 18432); LAS bf16* KHT = (LAS bf16*)(lds + 36864); LAS bf16* VT = (LAS bf16*)(lds + 54272); LAS bf16* P = (LAS bf16*)(lds + 89088);
    PSEG_B(lds, 2);
    { float qf[2][8], kf[2][8];
#pragma unroll
      for (int rr = 0; rr < 2; ++rr) { const unsigned qw[4] = {in.q[rr].x, in.q[rr].y, in.q[rr].z, in.q[rr].w}, kw[4] = {in.k[rr].x, in.k[rr].y, in.k[rr].z, in.k[rr].w};
#pragma unroll
          for (int j = 0; j < 4; ++j) { qf[rr][2 * j] = bf_lo(qw[j]); qf[rr][2 * j + 1] = bf_hi(qw[j]); kf[rr][2 * j] = bf_lo(kw[j]); kf[rr][2 * j + 1] = bf_hi(kw[j]); } }
      unsigned qt[2][4], kt[2][4]; float totv[8];
#pragma unroll
      for (int dd = 0; dd < 8; ++dd) { const float c0 = in.la[0][dd >> 2][dd & 3], c1 = c0 + in.la[1][dd >> 2][dd & 3]; float x = c1;
#pragma unroll
          for (int dl = 1; dl < 64; dl <<= 1) { const float y = __shfl_up(x, dl); x += (lane >= dl) ? y : 0.f; }
          const float tot = __int_as_float(__builtin_amdgcn_readlane(__float_as_int(x), 63)), bb0 = x - c1 + c0, bb1 = x; totv[dd] = tot;
          const unsigned q0 = f2bf(qf[0][dd] * __expf(bb0)), q1 = f2bf(qf[1][dd] * __expf(bb1)), k0 = f2bf(kf[0][dd] * __expf(-bb0)), k1 = f2bf(kf[1][dd] * __expf(-bb1));
          if (dd & 1) { qt[0][dd >> 1] |= q0 << 16; qt[1][dd >> 1] |= q1 << 16; kt[0][dd >> 1] |= k0 << 16; kt[1][dd >> 1] |= k1 << 16; } else { qt[0][dd >> 1] = q0; qt[1][dd >> 1] = q1; kt[0][dd >> 1] = k0; kt[1][dd >> 1] = k1; }
          *(LAS unsigned*)(KHT + (8 * wid + dd) * 136 + 2 * lane) = f2bf(kf[0][dd] * __expf(tot - bb0)) | (f2bf(kf[1][dd] * __expf(tot - bb1)) << 16); }
#pragma unroll
      for (int rr = 0; rr < 2; ++rr) { const v4u qv = (v4u){qt[rr][0], qt[rr][1], qt[rr][2], qt[rr][3]};
          *(LAS v4u*)(QTl + (2 * lane + rr) * 72 + 8 * wid) = qv; *(LAS v4u*)(KTl + (2 * lane + rr) * 72 + 8 * wid) = (v4u){kt[rr][0], kt[rr][1], kt[rr][2], kt[rr][3]};
          *(v4u*)(QTg + idx8((int)row0 + 2 * lane + rr, h * 64 + 8 * wid)) = qv; }
      if (lane == 0) { *(f32x4*)(DECg + (size_t)g * 64 + 8 * wid) = (f32x4){__expf(totv[0]), __expf(totv[1]), __expf(totv[2]), __expf(totv[3])}; *(f32x4*)(DECg + (size_t)g * 64 + 8 * wid + 4) = (f32x4){__expf(totv[4]), __expf(totv[5]), __expf(totv[6]), __expf(totv[7])}; } }
    { const unsigned v0[8] = {in.v[0][0].x, in.v[0][0].y, in.v[0][0].z, in.v[0][0].w, in.v[0][1].x, in.v[0][1].y, in.v[0][1].z, in.v[0][1].w};
      const unsigned v1[8] = {in.v[1][0].x, in.v[1][0].y, in.v[1][0].z, in.v[1][0].w, in.v[1][1].x, in.v[1][1].y, in.v[1][1].z, in.v[1][1].w};
#pragma unroll
      for (int j = 0; j < 8; ++j) { *(LAS unsigned*)(VT + (16 * wid + 2 * j) * 136 + 2 * lane) = (v0[j] & 0xffffu) | (v1[j] << 16); *(LAS unsigned*)(VT + (16 * wid + 2 * j + 1) * 136 + 2 * lane) = (v0[j] >> 16) | (v1[j] & 0xffff0000u); } }
    lds_barrier();
    PSEG_E(lds, 2); PSEG_B(lds, 3);
    const int fr = lane & 15, fq = lane >> 4, it = wid;
    { const bf16x8 qb0 = *(const LAS bf16x8*)(QTl + (it * 16 + fr) * 72 + fq * 8), qb1 = *(const LAS bf16x8*)(QTl + (it * 16 + fr) * 72 + 32 + fq * 8);
      const int i = it * 16 + fr;
      for (int jt = 0; jt <= it; ++jt) {
          const bf16x8 ka0 = *(const LAS bf16x8*)(KTl + (jt * 16 + fr) * 72 + fq * 8), ka1 = *(const LAS bf16x8*)(KTl + (jt * 16 + fr) * 72 + 32 + fq * 8);
          f32x4 a = (f32x4){0.f, 0.f, 0.f, 0.f};
          a = __builtin_amdgcn_mfma_f32_16x16x32_bf16(ka0, qb0, a, 0, 0, 0); a = __builtin_amdgcn_mfma_f32_16x16x32_bf16(ka1, qb1, a, 0, 0, 0);
          const int j0 = jt * 16 + 4 * fq; unsigned long long w = 0ull;
#pragma unroll
          for (int r = 0; r < 4; ++r) { const float v = (j0 + r <= i) ? a[r] : 0.f; w |= (unsigned long long)f2bf(v) << (16 * r); }
          *(LAS unsigned long long*)(P + i * 136 + j0) = w; }
      if (!(it & 1)) *(LAS unsigned long long*)(P + i * 136 + (it + 1) * 16 + 4 * fq) = 0ull; }
    lds_barrier();
    PSEG_E(lds, 3); PSEG_B(lds, 4);
    { const int nks = (it >> 1) + 1; bf16x8 pb[4];
#pragma unroll
      for (int kk = 0; kk < 4; ++kk) pb[kk] = *(const LAS bf16x8*)(P + (it * 16 + fr) * 136 + ((kk < nks) ? kk : 0) * 32 + fq * 8);
#pragma unroll
      for (int vt = 0; vt < 8; ++vt) { f32x4 o = (f32x4){0.f, 0.f, 0.f, 0.f};
#pragma unroll
          for (int kk = 0; kk < 4; ++kk) if (kk < nks) o = __builtin_amdgcn_mfma_f32_16x16x32_bf16(*(const LAS bf16x8*)(VT + (vt * 16 + fr) * 136 + kk * 32 + fq * 8), pb[kk], o, 0, 0, 0);
          *(unsigned long long*)(OIg + idx16((int)row0 + it * 16 + fr, h * 128 + vt * 16 + 4 * fq)) = (unsigned long long)pk2(o[0], o[1]) | ((unsigned long long)pk2(o[2], o[3]) << 32); }
      const int dt = wid & 3; bf16x8 ha[4];
#pragma unroll
      for (int kk = 0; kk < 4; ++kk) ha[kk] = *(const LAS bf16x8*)(KHT + (dt * 16 + fr) * 136 + kk * 32 + fq * 8);
#pragma unroll
      for (int vv = 0; vv < 4; ++vv) { const int vt = 4 * (wid >> 2) + vv; f32x4 sacc = (f32x4){0.f, 0.f, 0.f, 0.f};
#pragma unroll
          for (int kk = 0; kk < 4; ++kk) sacc = __builtin_amdgcn_mfma_f32_16x16x32_bf16(ha[kk], *(const LAS bf16x8*)(VT + (vt * 16 + fr) * 136 + kk * 32 + fq * 8), sacc, 0, 0, 0);
          *(f32x4*)(DSg + ((size_t)g * 128 + vt * 16 + fr) * 64 + dt * 16 + 4 * fq) = sacc; } }
    lds_barrier();
    PSEG_E(lds, 4);
}

__device__ __forceinline__ void conv_unit(int cu, LAS unsigned char* lds, const bf16* UBg, const float* cw, const float* cb, const float* cnw, const float* cnb, bf16* MIXg) {
    const int tid = opaque_tid(), c = tid; const int row0 = cu * 32, t0 = row0 & (T - 1);
    LAS bf16* U = (LAS bf16*)lds; LAS float* Y = (LAS float*)(lds + 63488); LAS float* STAT = (LAS float*)(lds + 129536);
    { v4u uv[8];
#pragma unroll
      for (int k = 0; k < 8; ++k) { const int e = min(tid + 512 * k, 62 * 64 - 1), r = e >> 6; const bool ok = (t0 + r >= 30);
          uv[k] = *(const v4u*)(UBg + (size_t)(ok ? row0 - 30 + r : row0) * CCH + (e & 63) * 8); if (!ok) uv[k] = (v4u){0u, 0u, 0u, 0u}; }
#pragma unroll
      for (int k = 0; k < 8; ++k) { const int e = min(tid + 512 * k, 62 * 64 - 1); *(LAS v4u*)(U + (size_t)e * 8) = uv[k]; } }
    float w[CW];
#pragma unroll
    for (int k = 0; k < CW; ++k) w[k] = cw[k * CCH + c];
    float y[32]; const float bias = cb[c];
#pragma unroll
    for (int i = 0; i < 32; ++i) y[i] = bias;
    lds_barrier();
    float uu[62];
#pragma unroll
    for (int p = 0; p < 62; ++p) uu[p] = bf2f(U[p * 512 + c]);
#pragma clang loop unroll(full)
    for (int k = 0; k < CW; ++k) {
#pragma clang loop unroll(full)
        for (int i = 0; i < 32; ++i) y[i] = fmaf(uu[i + k], w[k], y[i]);
    }
#pragma unroll
    for (int i = 0; i < 32; ++i) Y[i * 516 + c] = y[i];
    lds_barrier();
    { const int tt = tid >> 4, part = tid & 15; float s = 0.f, q = 0.f;
#pragma unroll
      for (int k = 0; k < 32; ++k) { const float v = Y[tt * 516 + part * 32 + ((k + part) & 31)]; s += v; q += v * v; }
#pragma unroll
      for (int o = 1; o < 16; o <<= 1) { s += __shfl_xor(s, o); q += __shfl_xor(q, o); }
      if (part == 0) { const float mean = s * (1.f / CCH); const float var = fmaxf(q * (1.f / CCH) - mean * mean, 0.f); STAT[tt * 2] = mean; STAT[tt * 2 + 1] = rsqrtf(var + EPS); } }
    lds_barrier();
    const float gw = cnw[c], gb = cnb[c];
#pragma unroll
    for (int i = 0; i < 32; ++i) { const float z = (y[i] - STAT[i * 2]) * STAT[i * 2 + 1] * gw + gb; U[i * 512 + c] = (bf16)f2bf(z * __builtin_amdgcn_rcpf(1.f + __expf(-z))); }
    lds_barrier();
#pragma unroll
    for (int k = 0; k < 4; ++k) { const int e = tid + 512 * k, r = e >> 6; *(v4u*)(MIXg + (size_t)(row0 + r) * D + 512 + (e & 63) * 8) = *(const LAS v4u*)(U + (size_t)e * 8); }
    lds_barrier();
}

__device__ __forceinline__ void gla_out_unit(int g, LAS unsigned char* lds, const bf16* QTg, const bf16* SPg, const bf16* OIg, const bf16* SGg, const float* gnw, bf16* MIXg) {
    const int tid = opaque_tid(), lane = tid & 63, wid = __builtin_amdgcn_readfirstlane(tid >> 6);
    const int bh = g >> 5, n = g & 31, b = bh >> 2, h = bh & 3; const size_t row0 = (size_t)b * T + n * CHUNK;
    LAS bf16* QTl = (LAS bf16*)lds; LAS bf16* ST = (LAS bf16*)(lds + 18432);
    { v4u qv[2], sv[2];
#pragma unroll
      for (int k = 0; k < 2; ++k) { const int e = tid + 512 * k, i = e >> 3, ds = (e & 7) * 8, e2 = e & 127, dg = e >> 7; qv[k] = *(const v4u*)(QTg + idx8((int)row0 + e2, h * 64 + 8 * dg)); sv[k] = *(const v4u*)(SPg + ((size_t)g * 128 + i) * 64 + ds); }
#pragma unroll
      for (int k = 0; k < 2; ++k) { const int e = tid + 512 * k, i = e >> 3, ds = (e & 7) * 8, e2 = e & 127, dg = e >> 7; *(LAS v4u*)(QTl + e2 * 72 + 8 * dg) = qv[k]; *(LAS v4u*)(ST + i * 72 + ds) = sv[k]; } }
    const int fr = lane & 15, fq = lane >> 4, it = wid; const size_t rowi = row0 + it * 16 + fr;
    unsigned long long oiv[8], sgv[8]; f32x4 gwv[8];
#pragma unroll
    for (int vt = 0; vt < 8; ++vt) { const int v0 = vt * 16 + 4 * fq; oiv[vt] = *(const unsigned long long*)(OIg + idx16((int)rowi, h * 128 + v0)); sgv[vt] = *(const unsigned long long*)(SGg + idx16((int)rowi, h * 128 + v0)); gwv[vt] = *(const f32x4*)(gnw + v0); }
    lds_barrier();
    const bf16x8 qb0 = *(const LAS bf16x8*)(QTl + (it * 16 + fr) * 72 + fq * 8), qb1 = *(const LAS bf16x8*)(QTl + (it * 16 + fr) * 72 + 32 + fq * 8);
    f32x4 o[8]; float ss = 0.f;
#pragma unroll
    for (int vt = 0; vt < 8; ++vt) {
        const bf16x8 sa0 = *(const LAS bf16x8*)(ST + (vt * 16 + fr) * 72 + fq * 8), sa1 = *(const LAS bf16x8*)(ST + (vt * 16 + fr) * 72 + 32 + fq * 8);
        f32x4 a = (f32x4){0.f, 0.f, 0.f, 0.f};
        a = __builtin_amdgcn_mfma_f32_16x16x32_bf16(sa0, qb0, a, 0, 0, 0); a = __builtin_amdgcn_mfma_f32_16x16x32_bf16(sa1, qb1, a, 0, 0, 0);
        const unsigned long long oi = oiv[vt];
        a[0] += bf_lo((unsigned)oi); a[1] += bf_hi((unsigned)oi); a[2] += bf_lo((unsigned)(oi >> 32)); a[3] += bf_hi((unsigned)(oi >> 32));
        o[vt] = a; ss += (a[0] * a[0] + a[1] * a[1]) + (a[2] * a[2] + a[3] * a[3]); }
    ss += __shfl_xor(ss, 16); ss += __shfl_xor(ss, 32);
    const float r = rsqrtf(ss * (1.f / DV) + EPS);
#pragma unroll
    for (int vt = 0; vt < 8; ++vt) { const int v0 = vt * 16 + 4 * fq; const f32x4 gw = gwv[vt]; const unsigned long long sg = sgv[vt];
        *(unsigned long long*)(MIXg + rowi * D + h * 128 + v0) = (unsigned long long)pk2(o[vt][0] * r * gw[0] * bf_lo((unsigned)sg), o[vt][1] * r * gw[1] * bf_hi((unsigned)sg))
            | ((unsigned long long)pk2(o[vt][2] * r * gw[2] * bf_lo((unsigned)(sg >> 32)), o[vt][3] * r * gw[3] * bf_hi((unsigned)(sg >> 32))) << 32); }
    lds_barrier();
}

struct Args { Inputs I; float* out; unsigned char* ws; int ph_lo, ph_hi, bslot, pad; };
__global__ void __launch_bounds__(NTHR, 2) mk_fwd(Args args) {
    extern __shared__ __attribute__((aligned(16))) unsigned char lds_raw[];
    LAS unsigned char* lds = (LAS unsigned char*)lds_raw;
    const int G = gridDim.x, bx = blockIdx.x;
#define PH_IDS const int tid = opaque_tid(), lane = tid & 63, wave = __builtin_amdgcn_readfirstlane(tid >> 6); (void)lane; (void)wave
    unsigned char* ws = args.ws; const Inputs& I = args.I; float* XA = args.out;
#define XB ((bf16*)(ws + WS_XB))
#define QS ((bf16*)(ws + WS_QS))
#define KB ((bf16*)(ws + WS_KB))
#define VB ((bf16*)(ws + WS_VB))
#define SG ((bf16*)(ws + WS_SG))
#define UB ((bf16*)(ws + WS_UB))
#define MIX ((bf16*)(ws + WS_MIX))
#define ACT ((bf16*)(ws + WS_ACT))
#define QT ((bf16*)(ws + WS_QT))
#define OI ((bf16*)(ws + WS_OI))
#define SP ((bf16*)(ws + WS_SP))
#define ACTM ((bf16*)(ws + WS_ACTM))
#define Y1 ((bf16*)(ws + WS_Y1))
#define SSQ ((float*)(ws + WS_SSQ))
#define LA ((float*)(ws + WS_LA))
#define DS ((float*)(ws + WS_DS))
#define DEC ((float*)(ws + WS_MISC + MI_DEC))
#define ROWG ((float*)(ws + WS_MISC + MI_ROWG))
#define SEL ((int*)(ws + WS_MISC + MI_SEL))
#define CNT ((int*)(ws + WS_MISC + MI_CNT))
#define ROWINFO ((int*)(ws + WS_MISC + MI_ROWINFO))
#define TILEE ((int*)(ws + WS_MISC + MI_TILEE))
    const int lo = args.ph_lo, hi = args.ph_hi;
    if (threadIdx.x < 4) ((LAS unsigned*)(lds + MISC_OFF))[threadIdx.x] = 0u;
#ifdef PROBE_SEG
    if (threadIdx.x == 0) { ((LAS unsigned long long*)(lds + MISC_OFF + 12288))[0] = 0ull; ((LAS unsigned long long*)(lds + MISC_OFF + 12288))[1] = 0ull; }
#endif
    __syncthreads();
    XcdBarrier bar; bar.bar = (unsigned*)(ws + WS_CTL) + 4096 * (1 + args.bslot); bar.x = 0; bar.st = nullptr;
    if (hi - lo > 1) bar = xcd_barrier_post((unsigned*)(ws + WS_CTL) + 4096 * (1 + args.bslot), (volatile LAS unsigned*)(lds + MISC_OFF));
#ifndef PHMASK
#define PHMASK 0x3ffff
#endif
#define IN(k) (((PHMASK >> ((k) >= 8 && (k) <= 12 ? (k) - 7 : (k))) & 1) && lo <= (k) && (k) < hi)
#define SEAM(k) do { if (IN(k) && IN((k) + 1)) xcd_barrier(bar); } while (0)

    if (IN(0)) { PH_IDS;
        LAS float* scr = (LAS float*)(lds + wave * 16384); const int gw = bx * NWAVES + wave, NGW = G * NWAVES;
        cvt_range(I, ws, gw, NGW, CVT_BF16, scr, lane);
        cvt_range(I, ws, CVT_BF16 + 6656 + gw, NGW, CVT_GU_END, scr, lane);
        for (int idx = bx * NTHR + tid; idx < 2 * 256 * 1024; idx += G * NTHR) cvt_gate_elem(I, ws, idx);
        for (int m = gw; m < M; m += NGW) row_to_xb(I.x + (size_t)m * D, XB + (size_t)m * D, SSQ + (size_t)m * 16, lane);
        __syncthreads();
    }
    SEAM(0);
    for (int l = 0; l < 2; ++l) {
        const int pb = 1 + 7 * l;
        const bf16* Win = (const bf16*)(ws + (l ? WS_WIN1 : WS_WIN0)); const bf16* Wout = (const bf16*)(ws + (l ? WS_WOUT1 : WS_WOUT0));
        if (IN(pb)) {
            pg8::StaticOrder<NIN / 256> S; S.init(M / 256, G, bx, Win);
            pg8::EpiIn E{SSQ, I.b_gate + l * KEY, QS, KB, VB, SG, UB, LA};
            pg8::gemm_phase<pg8::EpiIn, pg8::StaticOrder<NIN / 256>, true, true>(lds, (LAS float*)(lds + MISC_OFF + 64), XB, D, S, E);
            { constexpr int REM = ((M / 256) * (NIN / 256)) % 256, NF = (256 - REM) * NWAVES;
              if (G == 256 && bx >= REM) { PH_IDS; const int first = (l == 0 ? CVT_BF16 : CVT_GU_END); PSEG_B(lds, 20);
                  cvt_range(I, ws, first + (bx - REM) * NWAVES + wave, NF, first + 2560, (LAS float*)(lds + wave * 16384), lane); __syncthreads(); PSEG_E(lds, 20); }
              else if (G != 256 && l == 0) { PH_IDS; cvt_range(I, ws, CVT_BF16 + bx * NWAVES + wave, G * NWAVES, CVT_BF16 + 2560, (LAS float*)(lds + wave * 16384), lane); __syncthreads(); }
              else if (G != 256) { PH_IDS; cvt_range(I, ws, CVT_GU_END + bx * NWAVES + wave, G * NWAVES, CVT_GU_END + 2560, (LAS float*)(lds + wave * 16384), lane); __syncthreads(); } }
        }
        SEAM(pb);
        if (IN(pb + 1)) {
            constexpr int NGU_ = NB * H * NCH;
            for (int u = bx; u < NGU_; u += G) { PSEG_B(lds, 1); GlaIn gin; gla_chunk_load(u, gin, QS, KB, VB, LA); gla_chunk_unit(u, gin, lds, QT, OI, DS, DEC); PSEG_E(lds, 1); }
            for (int u = bx; u < 512; u += G) { PSEG_B(lds, 5); conv_unit(u, lds, UB, I.conv_w + l * CW * CCH, I.conv_b + l * CCH, I.cn_w + l * CCH, I.cn_b + l * CCH, MIX); PSEG_E(lds, 5); }
        }
        SEAM(pb + 1);
        if (IN(pb + 2)) { PH_IDS;
            for (int idx = bx * NTHR + tid; idx < NB * H * DV * DK; idx += G * NTHR) {
                const int bh = idx >> 13, vd = idx & 8191, d = idx & 63; float S = 0.f;
                const float* dsp = DS + (size_t)bh * NCH * 8192 + vd; const float* dcp = DEC + (size_t)bh * NCH * 64 + d; bf16* spp = SP + (size_t)bh * NCH * 8192 + vd;
                for (int nb = 0; nb < NCH; nb += 16) {
                    float dv[16], av[16];
#pragma unroll
                    for (int i = 0; i < 16; ++i) { dv[i] = dsp[(size_t)(nb + i) * 8192]; av[i] = dcp[(nb + i) * 64]; }
#pragma unroll
                    for (int i = 0; i < 16; ++i) { spp[(size_t)(nb + i) * 8192] = (bf16)f2bf(S); S = av[i] * S + dv[i]; }
                }
            }
        }
        SEAM(pb + 2);
        if (IN(pb + 3)) {
            for (int u = bx; u < NB * H * NCH; u += G) { PSEG_B(lds, 6); gla_out_unit(u, lds, QT, SP, OI, SG, I.gla_norm_w + l * DV, MIX); PSEG_E(lds, 6); }
        }
        SEAM(pb + 3);
        if (IN(pb + 4)) {
            pg8::StaticOrder<D / 256> S; S.init(M / 256, G, bx, Wout);
            pg8::EpiRes E{XB, SSQ, l == 1 ? ws + WS_XB8 : nullptr};
            pg8::gemm_phase<pg8::EpiRes, pg8::StaticOrder<D / 256>, true, true>(lds, (LAS float*)(lds + MISC_OFF + 64), MIX, D, S, E);
        }
        SEAM(pb + 4);
        if (l == 0) {
            if (IN(6)) {
                pg8::StaticOrder<NGU / 256, false> S; S.init(M / 256, G, bx, (const bf16*)(ws + WS_WDGU));
                pg8::EpiUp E{SSQ, ACT};
                pg8::gemm_phase<pg8::EpiUp, pg8::StaticOrder<NGU / 256, false>, true, true>(lds, (LAS float*)(lds + MISC_OFF + 64), XB, D, S, E);
                { constexpr int REM = ((M / 256) * (NGU / 256)) % 256;
                  PH_IDS; const int rank = (G == 256 && bx >= REM) ? bx - REM : (G == 256 ? -1 : bx), nf = (G == 256) ? 256 - REM : G;
                  if (rank >= 0) { PSEG_B(lds, 21); cvt_range(I, ws, CVT_BF16 + 2560 + rank * NWAVES + wave, nf * NWAVES, CVT_BF16 + 6656, (LAS float*)(lds + wave * 16384), lane); __syncthreads(); PSEG_E(lds, 21); } }
            }
            SEAM(6);
            if (IN(7)) {
                pg8::StaticOrder<D / 256> S; S.init(M / 256, G, bx, (const bf16*)(ws + WS_WDD));
                pg8::EpiRes E{XB, SSQ, nullptr};
                pg8::gemm_phase<pg8::EpiRes, pg8::StaticOrder<D / 256>, true, true>(lds, (LAS float*)(lds + MISC_OFF + 64), ACT, FF, S, E);
            }
            SEAM(7);
        }
    }
    if (IN(13)) { PH_IDS;
        LAS int* sel = (LAS int*)lds;
        f32x4 wq[4][4][2];
#pragma unroll
        for (int j = 0; j < 4; ++j)
#pragma unroll
            for (int c = 0; c < 4; ++c) { const int k = 256 * j + 4 * lane + c; const float lw = I.ln2_w[D + k]; const f32x4* wp = (const f32x4*)(I.w_router + (size_t)k * NE); wq[j][c][0] = wp[0] * lw; wq[j][c][1] = wp[1] * lw; }
        for (int rb = bx; rb < M / 64; rb += G) {
            unsigned long long xw[8][4];
#pragma unroll
            for (int k8 = 0; k8 < 8; ++k8) { const unsigned long long* xr = (const unsigned long long*)(XB + (size_t)(rb * 64 + wave * 8 + k8) * D) + lane;
#pragma unroll
                for (int j = 0; j < 4; ++j) xw[k8][j] = xr[64 * j]; }
            float val[9][8];
#pragma unroll
            for (int k8 = 0; k8 < 8; ++k8) {
                f32x4 l0 = (f32x4){0.f, 0.f, 0.f, 0.f}, l1 = l0; float ss = 0.f;
#pragma unroll
                for (int j = 0; j < 4; ++j) { const unsigned long long w8 = xw[k8][j];
                    const float xe[4] = {__uint_as_float((unsigned)(w8 << 16)), __uint_as_float((unsigned)w8 & 0xffff0000u), __uint_as_float((unsigned)(w8 >> 32) << 16), __uint_as_float((unsigned)(w8 >> 32) & 0xffff0000u)};
#pragma unroll
                    for (int c = 0; c < 4; ++c) { const float x = xe[c]; ss += x * x; l0 += wq[j][c][0] * x; l1 += wq[j][c][1] * x; } }
#pragma unroll
                for (int e = 0; e < 4; ++e) { val[e][k8] = l0[e]; val[4 + e][k8] = l1[e]; }
                val[8][k8] = ss;
            }
            const bool b5 = (lane & 32) != 0, b4 = (lane & 16) != 0, b3 = (lane & 8) != 0;
            float v1[9];
#pragma unroll
            for (int q = 0; q < 9; ++q) { float v4[4], v2[2];
#pragma unroll
                for (int t = 0; t < 4; ++t) { const float keep = b5 ? val[q][t + 4] : val[q][t], send = b5 ? val[q][t] : val[q][t + 4]; v4[t] = keep + __shfl_xor(send, 32); }
#pragma unroll
                for (int t = 0; t < 2; ++t) { const float keep = b4 ? v4[t + 2] : v4[t], send = b4 ? v4[t] : v4[t + 2]; v2[t] = keep + __shfl_xor(send, 16); }
                const float keep = b3 ? v2[1] : v2[0], send = b3 ? v2[0] : v2[1]; float x = keep + __shfl_xor(send, 8);
                x += __shfl_xor(x, 4); x += __shfl_xor(x, 2); x += __shfl_xor(x, 1); v1[q] = x; }
            { const int tk = lane >> 3, m = rb * 64 + wave * 8 + tk; const float r = rsqrtf(v1[8] * (1.f / D) + EPS);
                float lg[NE];
#pragma unroll
                for (int e = 0; e < NE; ++e) lg[e] = v1[e] * r;
                int e1 = 0; float vv1 = lg[0];
#pragma unroll
                for (int e = 1; e < NE; ++e) if (lg[e] > vv1) { vv1 = lg[e]; e1 = e; }
                int e2 = -1; float vv2 = -3.0e38f;
#pragma unroll
                for (int e = 0; e < NE; ++e) if (e != e1 && lg[e] > vv2) { vv2 = lg[e]; e2 = e; }
                const float p2 = __expf(vv2 - vv1), g1 = 1.f / (1.f + p2), g2 = p2 / (1.f + p2);
                if ((lane & 7) == 0) { SEL[m * 4 + 0] = e1; SEL[m * 4 + 1] = e2; SEL[m * 4 + 2] = __float_as_int(g1); SEL[m * 4 + 3] = __float_as_int(g2); sel[(wave * 8 + tk) * 2] = e1; sel[(wave * 8 + tk) * 2 + 1] = e2; }
            }
            __syncthreads();
            if (wave == 0) { const int e1 = sel[lane * 2], e2 = sel[lane * 2 + 1];
#pragma unroll
                for (int e = 0; e < NE; ++e) { const int cnt = __popcll(__ballot(e1 == e)) + __popcll(__ballot(e2 == e)); if (lane == 0) CNT[rb * NE + e] = cnt; } }
            __syncthreads();
        }
    }
    SEAM(13);
    if (IN(14)) { PH_IDS;
        if (wave > 0) cvt_range(I, ws, CVT_GU_END + 2560 + bx * (NWAVES - 1) + (wave - 1), G * (NWAVES - 1), CVT_GU_END + 4096, (LAS float*)(lds + wave * 16384), lane);
        LAS int* tab = (LAS int*)lds;
        for (int rb = bx; rb < M / 64; rb += G) {
            if (wave == 0) {
#pragma unroll
                for (int e = 0; e < NE; ++e) { int tot = 0, pre = 0;
#pragma unroll
                    for (int q = 0; q < 4; ++q) { const int r2 = lane + 64 * q; const int c = CNT[r2 * NE + e]; tot += c; pre += (r2 < rb) ? c : 0; }
#pragma unroll
                    for (int o = 1; o < 64; o <<= 1) { tot += __shfl_xor(tot, o); pre += __shfl_xor(pre, o); }
                    if (lane == 0) { tab[e] = tot; tab[16 + e] = pre; } }
                asm volatile("s_waitcnt lgkmcnt(0)" ::: "memory");
                if (lane == 0) { int off = 0;
                    for (int e = 0; e < NE; ++e) { tab[8 + e] = off; tab[16 + e] += off; off += ((tab[e] + 255) >> 8) << 8; }
                    tab[24] = off >> 8; }
                asm volatile("s_waitcnt lgkmcnt(0)" ::: "memory");
                const int m = rb * 64 + lane; const int e1 = SEL[m * 4], e2 = SEL[m * 4 + 1]; const float g1 = __int_as_float(SEL[m * 4 + 2]), g2 = __int_as_float(SEL[m * 4 + 3]);
                const unsigned long long lt = (1ull << lane) - 1ull;
#pragma unroll
                for (int e = 0; e < NE; ++e) { const unsigned long long m1 = __ballot(e1 == e), m2 = __ballot(e2 == e); const int base = tab[16 + e];
                    if (e1 == e) { const int pos = base + __popcll(m1 & lt); ROWINFO[pos] = m | 0x8000; ROWG[pos] = g1; }
                    if (e2 == e) { const int pos = base + __popcll(m1) + __popcll(m2 & lt); ROWINFO[pos] = m | 0x4000 | 0x8000; ROWG[pos] = g2; } }
                if (rb < NE) { const int tot = tab[rb], off = tab[8 + rb], pad = ((tot + 255) >> 8) << 8;
                    for (int p = tot + lane; p < pad; p += 64) { ROWINFO[off + p] = 0; ROWG[off + p] = 0.f; }
                    for (int tI = lane; tI < (pad >> 8); tI += 64) TILEE[(off >> 8) + tI] = rb; }
                if (rb == 0 && lane == 0) TILEE[255] = tab[24];
            }
            __syncthreads();
        }
    }
    SEAM(14);
    if (IN(15)) { PSEG_B(lds, 13);
        const int NT = __builtin_amdgcn_readfirstlane(__hip_atomic_load(TILEE + 255, __ATOMIC_RELAXED, __HIP_MEMORY_SCOPE_AGENT));
        LAS int* tile_l = (LAS int*)(lds + MISC_OFF + 8192);
        if (threadIdx.x < MAXTILES) tile_l[threadIdx.x] = TILEE[threadIdx.x];
        __syncthreads();
        pg8::MoeOrder<true, NGU / 256, false> S; S.init(NT, G, bx, ws + WS_WMGU, (size_t)NGU * D, tile_l, ROWINFO);
        pg8::EpiUpMoe E{SSQ, ROWINFO, ROWG, ws + WS_ACTM};
        pg8::gemm_phase<pg8::EpiUpMoe, pg8::MoeOrder<true, NGU / 256, false>, true, true, true, 0x79797979, 0x7f7f7f7f>(lds, (LAS float*)(lds + MISC_OFF + 64), ws + WS_XB8, D, S, E); PSEG_E(lds, 13);
        { const int rem = (NT * (NGU / 256)) % G; PH_IDS;
          if (bx >= rem) { cvt_range(I, ws, CVT_GU_END + 4096 + (bx - rem) * NWAVES + wave, (G - rem) * NWAVES, CVT_ITEMS, (LAS float*)(lds + wave * 16384), lane); __syncthreads(); } }
    }
    PSEG_B(lds, 14); SEAM(15); PSEG_E(lds, 14);
    if (IN(16)) {
        const int NT = __builtin_amdgcn_readfirstlane(__hip_atomic_load(TILEE + 255, __ATOMIC_RELAXED, __HIP_MEMORY_SCOPE_AGENT));
        LAS int* tile_l = (LAS int*)(lds + MISC_OFF + 8192);
        if (threadIdx.x < MAXTILES) tile_l[threadIdx.x] = TILEE[threadIdx.x];
        __syncthreads();
        pg8::MoeOrder<false, D / 256, false> S; S.init(NT, G, bx, ws + WS_WMD, (size_t)D * FF, tile_l, ROWINFO);
        pg8::EpiDownMoe E{ROWINFO, (bf16*)XA};
        pg8::gemm_phase<pg8::EpiDownMoe, pg8::MoeOrder<false, D / 256, false>, true, true, true, 0x79797979, 0x7b7b7b7b>(lds, (LAS float*)(lds + MISC_OFF + 64), ws + WS_ACTM, FF, S, E);
    }
    SEAM(16);
    if (IN(17)) { PH_IDS;
        const int gw = bx * NWAVES + wave, NGW = G * NWAVES;
        f32x4 wv[4];
#pragma unroll
        for (int j = 0; j < 4; ++j) wv[j] = ((const f32x4*)I.final_w)[lane + 64 * j];
        unsigned long long a0[4], a1[4], a2[4];
        int m = gw;
        if (m < M) { const unsigned long long* y0 = (const unsigned long long*)((const bf16*)XA + (size_t)m * 2048) + lane; const unsigned long long* xb = (const unsigned long long*)(XB + (size_t)m * D) + lane;
#pragma unroll
            for (int j = 0; j < 4; ++j) { a0[j] = y0[64 * j]; a1[j] = y0[256 + 64 * j]; a2[j] = xb[64 * j]; } }
        while (m < M) { const int mn = m + NGW; unsigned long long b0[4], b1[4], b2[4];
            if (mn < M) { const unsigned long long* y0 = (const unsigned long long*)((const bf16*)XA + (size_t)mn * 2048) + lane; const unsigned long long* xb = (const unsigned long long*)(XB + (size_t)mn * D) + lane;
#pragma unroll
                for (int j = 0; j < 4; ++j) { b0[j] = y0[64 * j]; b1[j] = y0[256 + 64 * j]; b2[j] = xb[64 * j]; } }
            f32x4 v[4]; float s = 0.f;
#pragma unroll
            for (int j = 0; j < 4; ++j) {
                v[j][0] = __uint_as_float((unsigned)(a0[j] << 16)) + __uint_as_float((unsigned)(a1[j] << 16)) + __uint_as_float((unsigned)(a2[j] << 16));
                v[j][1] = __uint_as_float((unsigned)a0[j] & 0xffff0000u) + __uint_as_float((unsigned)a1[j] & 0xffff0000u) + __uint_as_float((unsigned)a2[j] & 0xffff0000u);
                v[j][2] = __uint_as_float((unsigned)(a0[j] >> 32) << 16) + __uint_as_float((unsigned)(a1[j] >> 32) << 16) + __uint_as_float((unsigned)(a2[j] >> 32) << 16);
                v[j][3] = __uint_as_float((unsigned)(a0[j] >> 32) & 0xffff0000u) + __uint_as_float((unsigned)(a1[j] >> 32) & 0xffff0000u) + __uint_as_float((unsigned)(a2[j] >> 32) & 0xffff0000u);
                s += (v[j].x * v[j].x + v[j].y * v[j].y) + (v[j].z * v[j].z + v[j].w * v[j].w); }
            const float r = rsqrtf(wave_sum(s) * (1.f / D) + EPS);
            f32x4* xr = (f32x4*)(XA + (size_t)m * D) + lane;
#pragma unroll
            for (int j = 0; j < 4; ++j) xr[64 * j] = v[j] * r * wv[j];
#pragma unroll
            for (int j = 0; j < 4; ++j) { a0[j] = b0[j]; a1[j] = b1[j]; a2[j] = b2[j]; }
            m = mn; }
    }
#ifdef PROBE_SEG
#ifndef PROBE_WG
#define PROBE_WG 0
#endif
    if (blockIdx.x == PROBE_WG && threadIdx.x == 0) { const unsigned long long tacc = ((LAS unsigned long long*)(lds + MISC_OFF + 12288))[0], t0 = __builtin_amdgcn_s_memrealtime();
#ifdef PROBE_CYC
        while (__builtin_amdgcn_s_memrealtime() - t0 < tacc * PROBE_MULT / 20) __builtin_amdgcn_s_sleep(8); }
#else
        while (__builtin_amdgcn_s_memrealtime() - t0 < tacc * PROBE_MULT) __builtin_amdgcn_s_sleep(8); }
#endif
#endif
#undef IN
#undef SEAM
#undef PH_IDS
#undef XB
#undef QS
#undef KB
#undef VB
#undef SG
#undef UB
#undef MIX
#undef ACT
#undef QT
#undef OI
#undef SP
#undef ACTM
#undef Y1
#undef SSQ
#undef LA
#undef DS
#undef DEC
#undef ROWG
#undef SEL
#undef CNT
#undef ROWINFO
#undef TILEE
}
extern "C" void kernel_launch(void* const* d_in, const int* in_sizes, int n_in, void* d_out, int out_size, void* d_ws, size_t ws_size, hipStream_t stream) {
    static int grid = 0;
    if (grid == 0) {
        if (n_in != 20 || in_sizes[0] != M * D || out_size != M * D || ws_size < WS_END) { fprintf(stderr, "kernel_launch: unexpected shapes/workspace (n_in %d, ws %zu, need %zu)\n", n_in, ws_size, (size_t)WS_END); grid = -1; return; }
        int dev = 0, cus = 0, per_cu = 0;
        if (hipGetDevice(&dev) != hipSuccess || hipDeviceGetAttribute(&cus, hipDeviceAttributeMultiprocessorCount, dev) != hipSuccess) { grid = -1; return; }
        if (hipFuncSetAttribute((const void*)mk_fwd, hipFuncAttributeMaxDynamicSharedMemorySize, LDS_BYTES) != hipSuccess) { fprintf(stderr, "kernel_launch: hipFuncSetAttribute failed\n"); grid = -1; return; }
        if (hipOccupancyMaxActiveBlocksPerMultiprocessor(&per_cu, (const void*)mk_fwd, NTHR, LDS_BYTES) != hipSuccess || per_cu < 1) { fprintf(stderr, "kernel_launch: occupancy query says %d\n", per_cu); per_cu = 1; }
        (void)hipGetLastError();
        grid = cus;
    }
    if (grid < 0) return;
    unsigned char* ws = (unsigned char*)d_ws;
    (void)hipMemsetAsync(ws + WS_CTL, 0, 65536, stream);
    Args a{};
    { const float** p = (const float**)&a.I; for (int i = 0; i < 20; ++i) p[i] = (const float*)d_in[i]; }
    a.out = (float*)d_out; a.ws = ws; a.ph_lo = 0; a.ph_hi = 18;
#ifdef PROBE_PHASE
    a.ph_hi = PROBE_PHASE + 1; a.bslot = 0; hipLaunchKernelGGL(mk_fwd, dim3(grid), dim3(NTHR), LDS_BYTES, stream, a);
    a.ph_lo = PROBE_PHASE; a.bslot = 1; hipLaunchKernelGGL(mk_fwd, dim3(grid), dim3(NTHR), LDS_BYTES, stream, a);
    a.ph_lo = PROBE_PHASE + 1; a.ph_hi = 18; a.bslot = 2;
#endif
    hipLaunchKernelGGL(mk_fwd, dim3(grid), dim3(NTHR), LDS_BYTES, stream, a);
}
```
